# Optimizing an MI355X kernel written in HIP

```python
import math
import jax, jax.numpy as jnp
from jax import lax
import numpy as np

D_MODEL = 1024
BATCH = 4
SEQ = 8192
DEPTH = 2

GRID_W = 64
CTX_LEN = 256
HEAD_DIM = 64
ROPE_BASE = 10000.0
EPS = 1e-6
NEG_INF = -1e30
Q_BLOCK = 128

NA_HEADS = 8
NA_WIN_R = 8
NA_WIN_C = 16
NA_QCB = 16
NA_KCB = 32
NA_WIDTH = NA_HEADS * HEAD_DIM
NA_SCALE = HEAD_DIM ** -0.5

MLA_HEADS = 8
MLA_Q_LORA = 384
MLA_KV_LORA = 256
MLA_NOPE = 64
MLA_ROPE = 32
MLA_V = 64
MLA_QK = MLA_NOPE + MLA_ROPE
MLA_WIDTH = MLA_HEADS * MLA_V
MLA_SCALE = MLA_QK ** -0.5

DIFF_HEADS = 4
DIFF_D = 64
DIFF_V = 2 * DIFF_D
DIFF_QK_WIDTH = DIFF_HEADS * 2 * DIFF_D
DIFF_WIDTH = DIFF_HEADS * DIFF_V
DIFF_SCALE = DIFF_D ** -0.5

N_BRANCH = 3
BRANCH_WIDTH = 512

IN_SPLITS = (NA_WIDTH, NA_WIDTH, NA_WIDTH,
             MLA_Q_LORA, MLA_KV_LORA, MLA_ROPE,
             DIFF_QK_WIDTH, DIFF_QK_WIDTH, DIFF_WIDTH,
             N_BRANCH * BRANCH_WIDTH, N_BRANCH * D_MODEL)
D_IN = sum(IN_SPLITS)

kernel_name = "hybrid_natten_mla_diffattn_prefix_dit"


def rms_norm(x, g):
    xf = x.astype(jnp.float32)
    y = xf * lax.rsqrt(jnp.mean(xf * xf, axis=-1, keepdims=True) + EPS)
    return (y * g.astype(jnp.float32)).astype(x.dtype)


def axial_rope_tables(n_tokens, rot_dim):
    t = jnp.arange(n_tokens, dtype=jnp.int32)
    row = (t // GRID_W).astype(jnp.float32)
    col = (t % GRID_W).astype(jnp.float32)
    n_freq = rot_dim // 4
    inv = ROPE_BASE ** (-jnp.arange(n_freq, dtype=jnp.float32) / n_freq)
    ang = jnp.concatenate([row[:, None] * inv, col[:, None] * inv], axis=-1)
    return jnp.cos(ang), jnp.sin(ang)


def apply_rope(x, cos, sin):
    half = x.shape[-1] // 2
    shape = (cos.shape[0],) + (1,) * (x.ndim - 3) + (half,)
    cs = cos.reshape(shape).astype(x.dtype)
    sn = sin.reshape(shape).astype(x.dtype)
    x1, x2 = x[..., :half], x[..., half:]
    return jnp.concatenate([x1 * cs - x2 * sn, x2 * cs + x1 * sn], axis=-1)


def rope_tail(x, cos, sin, n_rot):
    return jnp.concatenate([x[..., :-n_rot], apply_rope(x[..., -n_rot:], cos, sin)], axis=-1)


def softmax_attend(q, k, v, scale):
    s = jnp.einsum('bqhd,bkhd->bhqk', q, k).astype(jnp.float32) * scale
    p = jax.nn.softmax(s, axis=-1).astype(v.dtype)
    return jnp.einsum('bhqk,bkhv->bqhv', p, v)


def diff_attend(q, k, v, lam, scale):
    s = jnp.einsum('bqhmd,bkhmd->bhmqk', q, k).astype(jnp.float32) * scale
    p = jax.nn.softmax(s, axis=-1)
    a = (p[:, :, 0] - lam * p[:, :, 1]).astype(v.dtype)
    return jnp.einsum('bhqk,bkhv->bqhv', a, v)


def blocked_queries(fn, q):
    B, T = q.shape[0], q.shape[1]
    nb = T // Q_BLOCK
    qb = jnp.moveaxis(q.reshape((B, nb, Q_BLOCK) + q.shape[2:]), 1, 0)
    out = lax.map(fn, qb)
    out = jnp.moveaxis(out, 0, 1)
    return out.reshape((B, T) + out.shape[3:])


def neighbourhood_attend(q, k, v, k_ctx, v_ctx, rpb):
    B, T, H, d = q.shape
    L = k_ctx.shape[1]
    rows = T // GRID_W
    kr = min(NA_WIN_R, rows)
    ncb = GRID_W // NA_QCB
    qcol = np.arange(GRID_W).reshape(ncb, NA_QCB)
    cstart = np.clip(qcol - NA_WIN_C // 2, 0, GRID_W - NA_WIN_C)
    band0 = np.clip(np.arange(ncb) * NA_QCB - NA_WIN_C // 2, 0, GRID_W - NA_KCB)
    kcol = band0[:, None] + np.arange(NA_KCB)
    kcol_f = np.tile(kcol, (1, kr))
    krow = np.repeat(np.arange(kr), NA_KCB)
    col_in = jnp.asarray((kcol_f[:, None, :] >= cstart[:, :, None])
                         & (kcol_f[:, None, :] < cstart[:, :, None] + NA_WIN_C))
    dc_idx = np.clip(kcol_f[:, None, :] - qcol[:, :, None], -(NA_WIN_C - 1), NA_WIN_C - 1) + (NA_WIN_C - 1)
    nk = kr * NA_KCB
    qg = q.reshape(B, rows, ncb, NA_QCB, H, d)
    kg = k.reshape(B, rows, GRID_W, H, d)
    vg = v.reshape(B, rows, GRID_W, H, d)

    def row_fn(r):
        rs = jnp.clip(r - kr // 2, 0, rows - kr)
        kb = lax.dynamic_slice_in_dim(kg, rs, kr, axis=1)[:, :, kcol]
        vb = lax.dynamic_slice_in_dim(vg, rs, kr, axis=1)[:, :, kcol]
        kb = kb.transpose(0, 2, 1, 3, 4, 5).reshape(B, ncb, nk, H, d)
        vb = vb.transpose(0, 2, 1, 3, 4, 5).reshape(B, ncb, nk, H, d)
        qr = lax.dynamic_index_in_dim(qg, r, axis=1, keepdims=False)
        dr = rs + krow - r + (NA_WIN_R - 1)
        bias = rpb[:, dr[None, None, :], dc_idx].astype(jnp.float32)
        s_lat = jnp.einsum('bnqhd,bnkhd->bhnqk', qr, kb).astype(jnp.float32) * NA_SCALE + bias
        s_lat = jnp.where(col_in, s_lat, NEG_INF)
        s_ctx = jnp.einsum('bnqhd,bkhd->bhnqk', qr, k_ctx).astype(jnp.float32) * NA_SCALE
        p = jax.nn.softmax(jnp.concatenate([s_ctx, s_lat], axis=-1), axis=-1).astype(v.dtype)
        return (jnp.einsum('bhnqk,bkhd->bnqhd', p[..., :L], v_ctx)
                + jnp.einsum('bhnqk,bnkhd->bnqhd', p[..., L:], vb))

    out = lax.map(row_fn, jnp.arange(rows))
    return out.transpose(1, 0, 2, 3, 4, 5).reshape(B, T, H * d)


def mixer_inputs(h, w_in_l, na_q_g, na_k_g, mla_cq_g, mla_ckv_g, w_uq_l, w_ukv_l,
                 mla_q_g, mla_k_g, diff_q_g, diff_k_g):
    lead = h.shape[:-1]
    split_points = [int(s) for s in np.cumsum(IN_SPLITS)[:-1]]
    (na_q, na_k, na_v, cq, ckv, k_rope, dq, dk, dv, z, gm) = jnp.split(h @ w_in_l, split_points, axis=-1)
    na_q = rms_norm(na_q.reshape(lead + (NA_HEADS, HEAD_DIM)), na_q_g)
    na_k = rms_norm(na_k.reshape(lead + (NA_HEADS, HEAD_DIM)), na_k_g)
    na_v = na_v.reshape(lead + (NA_HEADS, HEAD_DIM))
    mq = (rms_norm(cq, mla_cq_g) @ w_uq_l).reshape(lead + (MLA_HEADS, MLA_QK))
    kv = (rms_norm(ckv, mla_ckv_g) @ w_ukv_l).reshape(lead + (MLA_HEADS, MLA_NOPE + MLA_V))
    k_nope, mv = kv[..., :MLA_NOPE], kv[..., MLA_NOPE:]
    k_r = jnp.broadcast_to(k_rope[..., None, :], lead + (MLA_HEADS, MLA_ROPE))
    mk = rms_norm(jnp.concatenate([k_nope, k_r], axis=-1), mla_k_g)
    mq = rms_norm(mq, mla_q_g)
    dq = rms_norm(dq.reshape(lead + (DIFF_HEADS, 2, DIFF_D)), diff_q_g)
    dk = rms_norm(dk.reshape(lead + (DIFF_HEADS, 2, DIFF_D)), diff_k_g)
    dv = dv.reshape(lead + (DIFF_HEADS, DIFF_V))
    return (na_q, na_k, na_v, mq, mk, mv, dq, dk, dv, z, gm)


def diff_finish(o, subln_g, lam_init):
    o = rms_norm(o, subln_g) * (1.0 - lam_init)
    return o.reshape(o.shape[:-2] + (DIFF_WIDTH,))


def merge_branches(o_na, o_mla, o_diff, z, gm, w_br_l, w_out_l):
    z_na, z_mla, z_diff = jnp.split(z, N_BRANCH, axis=-1)
    g_na, g_mla, g_diff = jnp.split(gm, N_BRANCH, axis=-1)
    y = (jax.nn.sigmoid(g_na) * ((o_na * jax.nn.silu(z_na)) @ w_br_l[0])
         + jax.nn.sigmoid(g_mla) * ((o_mla * jax.nn.silu(z_mla)) @ w_br_l[1])
         + jax.nn.sigmoid(g_diff) * ((o_diff * jax.nn.silu(z_diff)) @ w_br_l[2]))
    return y @ w_out_l


def setup_inputs(seed: int = 0) -> dict:
    key = jax.random.key(seed)
    ks = jax.random.split(key, 26)
    f32 = jnp.float32

    def nrm(k, shape, s):
        return jax.random.normal(k, shape, f32) * s

    def gain(k, shape):
        return 1.0 + 0.05 * jax.random.normal(k, shape, f32)

    D = D_MODEL
    return {
        'x': nrm(ks[0], (BATCH, SEQ, D), 1.0),
        'c': nrm(ks[1], (BATCH, D), 1.0),
        'ctx': nrm(ks[2], (BATCH, CTX_LEN, D), 1.0),
        'c_ctx': nrm(ks[3], (D,), 1.0),
        'norm_g': gain(ks[4], (DEPTH, D)),
        'w_ada': nrm(ks[5], (DEPTH, D, 3 * D), D ** -0.5),
        'b_ada': nrm(ks[6], (DEPTH, 3 * D), 0.02),
        'w_in': nrm(ks[7], (DEPTH, D, D_IN), D ** -0.5),
        'na_rpb': nrm(ks[8], (DEPTH, NA_HEADS, 2 * NA_WIN_R - 1, 2 * NA_WIN_C - 1), 0.1),
        'na_q_g': gain(ks[9], (DEPTH, HEAD_DIM)),
        'na_k_g': gain(ks[10], (DEPTH, HEAD_DIM)),
        'mla_cq_g': gain(ks[11], (DEPTH, MLA_Q_LORA)),
        'mla_ckv_g': gain(ks[12], (DEPTH, MLA_KV_LORA)),
        'w_uq': nrm(ks[13], (DEPTH, MLA_Q_LORA, MLA_HEADS * MLA_QK), MLA_Q_LORA ** -0.5),
        'w_ukv': nrm(ks[14], (DEPTH, MLA_KV_LORA, MLA_HEADS * (MLA_NOPE + MLA_V)), MLA_KV_LORA ** -0.5),
        'mla_q_g': gain(ks[15], (DEPTH, MLA_QK)),
        'mla_k_g': gain(ks[16], (DEPTH, MLA_QK)),
        'diff_q_g': gain(ks[17], (DEPTH, DIFF_D)),
        'diff_k_g': gain(ks[18], (DEPTH, DIFF_D)),
        'diff_lq1': nrm(ks[19], (DEPTH, DIFF_D), 0.1),
        'diff_lk1': nrm(ks[20], (DEPTH, DIFF_D), 0.1),
        'diff_lq2': nrm(ks[21], (DEPTH, DIFF_D), 0.1),
        'diff_lk2': nrm(ks[22], (DEPTH, DIFF_D), 0.1),
        'diff_subln_g': gain(ks[23], (DEPTH, DIFF_V)),
        'w_br': nrm(ks[24], (DEPTH, N_BRANCH, BRANCH_WIDTH, D), BRANCH_WIDTH ** -0.5),
        'w_out': nrm(ks[25], (DEPTH, D, D), D ** -0.5),
    }


def reference(x, c, ctx, c_ctx, norm_g, w_ada, b_ada, w_in, na_rpb, na_q_g, na_k_g,
              mla_cq_g, mla_ckv_g, w_uq, w_ukv, mla_q_g, mla_k_g, diff_q_g, diff_k_g,
              diff_lq1, diff_lk1, diff_lq2, diff_lk2, diff_subln_g, w_br, w_out):
    B, T, _ = x.shape
    f32 = jnp.float32
    cos_m, sin_m = axial_rope_tables(T, MLA_ROPE)
    cos_d, sin_d = axial_rope_tables(T, DIFF_D)
    for l in range(DEPTH):
        last = l == DEPTH - 1
        lam_init = 0.8 - 0.6 * math.exp(-0.3 * l)
        lam = (jnp.exp(jnp.sum(diff_lq1[l].astype(f32) * diff_lk1[l].astype(f32)))
               - jnp.exp(jnp.sum(diff_lq2[l].astype(f32) * diff_lk2[l].astype(f32))) + lam_init)
        shift, scale, gate = jnp.split(jax.nn.silu(c) @ w_ada[l] + b_ada[l], 3, axis=-1)
        shift_c, scale_c, gate_c = jnp.split(jax.nn.silu(c_ctx) @ w_ada[l] + b_ada[l], 3, axis=-1)
        h = rms_norm(x, norm_g[l]) * (1.0 + scale[:, None]) + shift[:, None]
        hc = rms_norm(ctx, norm_g[l]) * (1.0 + scale_c) + shift_c
        params = (w_in[l], na_q_g[l], na_k_g[l], mla_cq_g[l], mla_ckv_g[l], w_uq[l], w_ukv[l],
                  mla_q_g[l], mla_k_g[l], diff_q_g[l], diff_k_g[l])
        (na_q, na_k, na_v, m_q, m_k, m_v, d_q, d_k, d_v, z, gm) = mixer_inputs(h, *params)
        (cna_q, cna_k, cna_v, cm_q, cm_k, cm_v, cd_q, cd_k, cd_v, cz, cgm) = mixer_inputs(hc, *params)
        m_q = rope_tail(m_q, cos_m, sin_m, MLA_ROPE)
        m_k = rope_tail(m_k, cos_m, sin_m, MLA_ROPE)
        d_q = apply_rope(d_q, cos_d, sin_d)
        d_k = apply_rope(d_k, cos_d, sin_d)
        m_k_all = jnp.concatenate([cm_k, m_k], axis=1)
        m_v_all = jnp.concatenate([cm_v, m_v], axis=1)
        d_k_all = jnp.concatenate([cd_k, d_k], axis=1)
        d_v_all = jnp.concatenate([cd_v, d_v], axis=1)
        o_na = neighbourhood_attend(na_q, na_k, na_v, cna_k, cna_v, na_rpb[l])
        o_mla = blocked_queries(lambda qb: softmax_attend(qb, m_k_all, m_v_all, MLA_SCALE), m_q)
        o_mla = o_mla.reshape(B, T, MLA_WIDTH)
        o_diff = blocked_queries(lambda qb: diff_attend(qb, d_k_all, d_v_all, lam, DIFF_SCALE), d_q)
        o_diff = diff_finish(o_diff, diff_subln_g[l], lam_init)
        x_new = x + gate[:, None] * merge_branches(o_na, o_mla, o_diff, z, gm, w_br[l], w_out[l])
        if not last:
            co_na = softmax_attend(cna_q, cna_k, cna_v, NA_SCALE).reshape(B, -1, NA_WIDTH)
            co_mla = softmax_attend(cm_q, cm_k, cm_v, MLA_SCALE).reshape(B, -1, MLA_WIDTH)
            co_diff = diff_finish(diff_attend(cd_q, cd_k, cd_v, lam, DIFF_SCALE), diff_subln_g[l], lam_init)
            ctx = ctx + gate_c * merge_branches(co_na, co_mla, co_diff, cz, cgm, w_br[l], w_out[l])
        x = x_new
    return x
```

```cpp
#include <hip/hip_runtime.h>
#include <hip/hip_cooperative_groups.h>
#include <cstdio>
namespace cg = cooperative_groups;

typedef unsigned short u16;
typedef short bf16x8 __attribute__((ext_vector_type(8)));
typedef short s16x4 __attribute__((ext_vector_type(4)));
typedef float f32x16 __attribute__((ext_vector_type(16)));
typedef float f32x2 __attribute__((ext_vector_type(2)));
typedef __bf16 bf16x2_t __attribute__((ext_vector_type(2)));

#define DEV __device__ __forceinline__
#define MFMA(a, b, c) __builtin_amdgcn_mfma_f32_32x32x16_bf16((a), (b), (c), 0, 0, 0)

#ifndef REP_INPROJ
#define REP_INPROJ 1
#endif
#ifndef REP_DIFF
#define REP_DIFF 1
#endif
#ifndef REP_MLA
#define REP_MLA 1
#endif
#ifndef REP_NA
#define REP_NA 1
#endif
constexpr int NB = 4, SEQ = 8192, CTXL = 256, DM = 1024;
constexpr int TP = SEQ + CTXL;
constexpr int MH = 2 * TP;
constexpr int MALL = 4 * TP;
constexpr int NIN = 8448;
constexpr int DIN = 8352;
constexpr float EPS = 1e-6f;
constexpr float LOG2E = 1.4426950408889634f;

constexpr size_t SZ_WIN = (size_t)2 * NIN * 1024 * 2;
constexpr size_t SZ_WUQ = (size_t)2 * 1024 * 384 * 2;
constexpr size_t SZ_WUKV = (size_t)2 * 1024 * 256 * 2;
constexpr size_t SZ_WBR = (size_t)2 * 3 * 1024 * 512 * 2;
constexpr size_t SZ_WOUT = (size_t)2 * 1024 * 1024 * 2;
constexpr size_t SZ_MOD = (size_t)2 * 5 * 3072 * 4;
constexpr size_t SZ_LAM = 256;
constexpr size_t SZ_CTX1 = (size_t)NB * CTXL * DM * 4;
constexpr size_t SZ_H = (size_t)MALL * 1024 * 2;
constexpr size_t SZ_HD = (size_t)MH * 512 * 2;
constexpr size_t SZ_CQ = (size_t)MH * 384 * 2;
constexpr size_t SZ_CKV = (size_t)MH * 256 * 2;
constexpr size_t SZ_KROPE = (size_t)MH * 32 * 4;
constexpr size_t SZ_SSQ = (size_t)MH * 16 * 4;
constexpr size_t SZ_Z = (size_t)MH * 1536 * 2;
constexpr size_t SZ_G = (size_t)MH * 3072 * 2;
constexpr size_t SZ_MQ = (size_t)MH * 768 * 2;

constexpr size_t OFF_WIN = 0;
constexpr size_t OFF_WUQ = OFF_WIN + SZ_WIN;
constexpr size_t OFF_WUKV = OFF_WUQ + SZ_WUQ;
constexpr size_t OFF_WBR = OFF_WUKV + SZ_WUKV;
constexpr size_t OFF_WOUT = OFF_WBR + SZ_WBR;
constexpr size_t OFF_MOD = OFF_WOUT + SZ_WOUT;
constexpr size_t OFF_LAM = OFF_MOD + SZ_MOD;
constexpr size_t OFF_CTX1 = OFF_LAM + SZ_LAM;
constexpr size_t OFF_H = OFF_CTX1 + SZ_CTX1;
constexpr size_t OFF_NAQ = OFF_H + SZ_H;
constexpr size_t OFF_NAK = OFF_NAQ + SZ_HD;
constexpr size_t OFF_NAV = OFF_NAK + SZ_HD;
constexpr size_t OFF_CQ = OFF_NAV + SZ_HD;
constexpr size_t OFF_CKV = OFF_CQ + SZ_CQ;
constexpr size_t OFF_KROPE = OFF_CKV + SZ_CKV;
constexpr size_t OFF_SSQ = OFF_KROPE + SZ_KROPE;
constexpr size_t OFF_DQ = OFF_SSQ + SZ_SSQ;
constexpr size_t OFF_DK = OFF_DQ + SZ_HD;
constexpr size_t OFF_DV = OFF_DK + SZ_HD;
constexpr size_t OFF_Z = OFF_DV + SZ_HD;
constexpr size_t OFF_G = OFF_Z + SZ_Z;
constexpr size_t OFF_MQ = OFF_G + SZ_G;
constexpr size_t OFF_MK = OFF_MQ + SZ_MQ;
constexpr size_t OFF_MV = OFF_MK + SZ_MQ;
constexpr size_t OFF_ACAT = OFF_MV + SZ_HD;
constexpr size_t OFF_BAR = OFF_ACAT + SZ_Z;
constexpr size_t SZ_BAR = 16384;
constexpr size_t WS_NEED = OFF_BAR + SZ_BAR;

constexpr int SMEM_BYTES = 3 * 49152;

struct Params {
  const float *x, *c, *ctx, *c_ctx, *norm_g, *w_ada, *b_ada, *w_in, *na_rpb, *na_q_g, *na_k_g, *mla_cq_g,
      *mla_ckv_g, *w_uq, *w_ukv, *mla_q_g, *mla_k_g, *diff_q_g, *diff_k_g, *diff_lq1, *diff_lk1, *diff_lq2,
      *diff_lk2, *diff_subln_g, *w_br, *w_out;
  float* out;
  char* ws;
};

template <typename T> DEV T* opaque_ptr(T* q) { asm volatile("" : "+s"(q)); return q; }
DEV int opaque_tid() { int t = threadIdx.x; asm volatile("" : "+v"(t)); return t; }
DEV float bf2f(u16 v) { return __uint_as_float(((unsigned)v) << 16); }
DEV unsigned pk2(float a, float b) {
  f32x2 v = {a, b};
  bf16x2_t r = __builtin_convertvector(v, bf16x2_t);
  return __builtin_bit_cast(unsigned, r);
}
DEV uint2 pk4(float a, float b, float c, float d) { return make_uint2(pk2(a, b), pk2(c, d)); }
DEV float fast_exp2(float x) { return __builtin_amdgcn_exp2f(x); }
DEV float fast_rcp(float x) { return __builtin_amdgcn_rcpf(x); }
DEV float sigmoidf_(float v) { return fast_rcp(1.f + fast_exp2(-v * LOG2E)); }
DEV float siluf_(float v) { return v * sigmoidf_(v); }
DEV float xor32(float v) { return __shfl_xor(v, 32, 64); }
DEV float half_max(float v) {
  const unsigned u = __float_as_uint(v);
  auto r = __builtin_amdgcn_permlane32_swap(u, u, false, false);
  return fmaxf(__uint_as_float(r[0]), __uint_as_float(r[1]));
}
DEV int crow_of(int reg, int h) { return (reg & 3) + 8 * (reg >> 2) + 4 * h; }
DEV void store_row32(u16* base32, const float (&v)[16], int h) {
  uint2 p[4];
#pragma unroll
  for (int g = 0; g < 4; ++g) p[g] = pk4(v[4 * g], v[4 * g + 1], v[4 * g + 2], v[4 * g + 3]);
#pragma unroll
  for (int k = 0; k < 4; k += 2) {
    auto rx = __builtin_amdgcn_permlane32_swap(p[k].x, p[k + 1].x, false, false);
    auto ry = __builtin_amdgcn_permlane32_swap(p[k].y, p[k + 1].y, false, false);
    *(uint4*)((char*)base32 + (h ? 16 : 0) + 16 * k) = make_uint4(rx[0], ry[0], rx[1], ry[1]);
  }
}

DEV void sincos_fast(float a, float& s, float& c) {
  float rev = a * 0.15915494309189535f;
  rev = rev - floorf(rev);
  s = __builtin_amdgcn_sinf(rev);
  c = __builtin_amdgcn_cosf(rev);
}

struct NoPre { DEV void operator()() const {} };

template <int NI, int MJ, int BROWS, int NSTG, typename Pre = NoPre>
DEV void gemm_main(f32x16 (&acc)[NI][MJ], const u16* __restrict__ A, int lda, const u16* __restrict__ Bt, int ldb,
                   int K, char* smem, int wrow_act, int wrow_w, int ksa = 64, int ksb = 64, Pre pre = Pre()) {
  constexpr int ABYTES = 256 * 128;
  constexpr int STAGE = ABYTES + (BROWS > 128 ? BROWS : 128) * 128;
  constexpr int NSB = BROWS / 64;
  constexpr int NLD = 4 + NSB;
  constexpr int DIST = NSTG - 1;
  const int tid = opaque_tid(), lane = tid & 63, h = lane >> 5, r = lane & 31;
  const int nk = K >> 6;
  const int cch = (tid & 7) ^ ((tid >> 4) & 7);
  const u16* ga = A + (size_t)(tid >> 3) * lda + cch * 8;
  const u16* gb = Bt + (size_t)(tid >> 3) * ldb + cch * 8;
  char* lds_t = smem + tid * 16;
  auto issue_piece = [&](int kt, int pc) {
    char* st = lds_t + (kt % NSTG) * STAGE;
    if (pc < 4)
      __builtin_amdgcn_global_load_lds((const unsigned*)(ga + (size_t)(64 * pc) * lda + (size_t)kt * ksa), (unsigned __attribute__((address_space(3)))*)(st + pc * 8192), 16, 0, 0);
    else
      __builtin_amdgcn_global_load_lds((const unsigned*)(gb + (size_t)(64 * (pc - 4)) * ldb + (size_t)kt * ksb), (unsigned __attribute__((address_space(3)))*)(st + ABYTES + (pc - 4) * 8192), 16, 0, 0);
  };
  const int x = (r >> 1) & 7;
  int xo[4];
#pragma unroll
  for (int s = 0; s < 4; ++s) xo[s] = (((2 * s + h) ^ x) << 4);
  asm volatile("s_waitcnt vmcnt(0)" ::: "memory");
#pragma unroll
  for (int d = 0; d < DIST; ++d)
#pragma unroll
    for (int pc = 0; pc < NLD; ++pc) issue_piece(d, pc);
  pre();
  for (int kt = 0; kt < nk; ++kt) {
    if (DIST == 2 && kt + 1 < nk) {
      if (NLD == 6) asm volatile("s_waitcnt vmcnt(6)" ::: "memory");
      else if (NLD == 5) asm volatile("s_waitcnt vmcnt(5)" ::: "memory");
      else asm volatile("s_waitcnt vmcnt(8)" ::: "memory");
    } else {
      asm volatile("s_waitcnt vmcnt(0)" ::: "memory");
    }
    __builtin_amdgcn_s_barrier();
    const bool pre = (kt + DIST < nk);
    const char* base = smem + (kt % NSTG) * STAGE;
    const char* pa = base + (wrow_act + r) * 128;
    const char* pw = base + ABYTES + (wrow_w + r) * 128;
    constexpr int NM = NI * MJ;
    constexpr int PPS = (NLD + 1) / 2;
#pragma unroll
    for (int s = 0; s < 4; ++s) {
      bf16x8 af[MJ], wf[NI];
#pragma unroll
      for (int j = 0; j < MJ; ++j) af[j] = *(const bf16x8*)(pa + j * 32 * 128 + xo[s]);
#pragma unroll
      for (int i = 0; i < NI; ++i) wf[i] = *(const bf16x8*)(pw + i * 32 * 128 + xo[s]);
#pragma unroll
      for (int m = 0; m < NM; ++m) {
        const int i = m / MJ, j = m % MJ;
        acc[i][j] = MFMA(wf[i], af[j], acc[i][j]);
        if (s < 2 && NM >= PPS) {
          constexpr int EVERY = (NM / PPS) > 0 ? (NM / PPS) : 1;
          if ((m + 1) % EVERY == 0) {
            const int pc = s * PPS + (m + 1) / EVERY - 1;
            if ((m + 1) / EVERY <= PPS && pc < NLD) {
              __builtin_amdgcn_sched_barrier(0);
              if (pre) issue_piece(kt + DIST, pc);
              __builtin_amdgcn_sched_barrier(0);
            }
          }
        }
        if (s < 2 && NM < PPS) {
          const int slot = s * NM + m;
          __builtin_amdgcn_sched_barrier(0);
#pragma unroll
          for (int pc = 0; pc < NLD; ++pc)
            if ((pc * 2 * NM) / NLD == slot && pre) issue_piece(kt + DIST, pc);
          __builtin_amdgcn_sched_barrier(0);
        }
      }
    }
  }
  __builtin_amdgcn_s_barrier();
}

DEV bool tile_decode(int t, int MT, int NT, int GM, int& mt, int& nt) {
  const int total = MT * NT;
  const int L = (total + 7) >> 3;
  const int x = t & 7, s = t >> 3;
  if (s >= L) return false;
  const int p = x * L + s;
  if (p >= total) return false;
  const int gsz = GM * NT;
  const int mg = p / gsz, rem = p - mg * gsz;
  const int gm = min(GM, MT - mg * GM);
  nt = rem / gm;
  mt = mg * GM + (rem - nt * gm);
  return true;
}

DEV void transpose_item(const float* __restrict__ src, int ld_src, int k0, int n0, int Kdim, u16* __restrict__ dst,
                        int mapmode  , const float* __restrict__ rowscale, char* smem) {
  float* tile = (float*)smem;
  const int tid = opaque_tid();
  {
    const int k = tid >> 3, c8 = (tid & 7) * 8;
    float4 v0 = make_float4(0, 0, 0, 0), v1 = v0;
    const int nd = n0 + c8;
    int sc = nd;
    if (mapmode == 1) sc = (nd < 2208) ? nd : (nd < 2304 ? -1 : nd - 96);
    else if (mapmode == 2) sc = ((nd & 127) < 96) ? (nd >> 7) * 96 + (nd & 127) : -1;
    if (sc >= 0) {
      const float* sp = src + (size_t)(k0 + k) * ld_src + sc;
      v0 = *(const float4*)sp;
      v1 = *(const float4*)(sp + 4);
      if (rowscale) {
        const float g = rowscale[k0 + k];
        v0.x *= g; v0.y *= g; v0.z *= g; v0.w *= g; v1.x *= g; v1.y *= g; v1.z *= g; v1.w *= g;
      }
    }
    float* tp = tile + k * 65 + c8;
    tp[0] = v0.x; tp[1] = v0.y; tp[2] = v0.z; tp[3] = v0.w; tp[4] = v1.x; tp[5] = v1.y; tp[6] = v1.z; tp[7] = v1.w;
  }
  __syncthreads();
  {
    const int n = tid >> 3, kc = (tid & 7) * 8;
    float v[8];
#pragma unroll
    for (int e = 0; e < 8; ++e) v[e] = tile[(kc + e) * 65 + n];
    uint4 o = make_uint4(pk2(v[0], v[1]), pk2(v[2], v[3]), pk2(v[4], v[5]), pk2(v[6], v[7]));
    if (mapmode == 1) {
      const int nn = n0 + n;
      *(uint4*)(dst + (size_t)(nn >> 8) * (256 * 1024) + (size_t)(k0 >> 6) * (256 * 64) + (nn & 255) * 64 + kc) = o;
    } else {
      *(uint4*)(dst + (size_t)(n0 + n) * Kdim + k0 + kc) = o;
    }
  }
  __syncthreads();
}

DEV void phase_prologue(const Params& p, char* smem) {
  char* ws = opaque_ptr(p.ws);
  constexpr int N_WIN = 2 * 16 * 132, N_WUQ = 2 * 6 * 16, N_WUKV = 2 * 4 * 16, N_WBR = 6 * 8 * 16, N_WOUT = 2 * 16 * 16,
                N_MOD = 96;
  constexpr int E0 = N_WIN, E1 = E0 + N_WUQ, E2 = E1 + N_WUKV, E3 = E2 + N_WBR, E4 = E3 + N_WOUT, E5 = E4 + N_MOD,
                E6 = E5 + 1;
  for (int it = blockIdx.x; it < E6; it += gridDim.x) {
    if (it < E0) {
      const int l = it / (16 * 132), r = it % (16 * 132), kt = r / 132, nt = r % 132;
      transpose_item(p.w_in + (size_t)l * 1024 * DIN, DIN, kt * 64, nt * 64, 1024, (u16*)(ws + OFF_WIN) + (size_t)l * NIN * 1024,
                     1, nullptr, smem);
    } else if (it < E1) {
      const int q = it - E0, l = q / 96, r = q % 96, kt = r / 16, nt = r % 16;
      transpose_item(p.w_uq + (size_t)l * 384 * 768, 768, kt * 64, nt * 64, 384, (u16*)(ws + OFF_WUQ) + (size_t)l * 1024 * 384, 2,
                     p.mla_cq_g + l * 384, smem);
    } else if (it < E2) {
      const int q = it - E1, l = q / 64, r = q % 64, kt = r / 16, nt = r % 16;
      transpose_item(p.w_ukv + (size_t)l * 256 * 1024, 1024, kt * 64, nt * 64, 256,
                     (u16*)(ws + OFF_WUKV) + (size_t)l * 1024 * 256, 0, p.mla_ckv_g + l * 256, smem);
    } else if (it < E3) {
      const int q = it - E2, mat = q / 128, r = q % 128, kt = r / 16, nt = r % 16;
      transpose_item(p.w_br + (size_t)mat * 512 * 1024, 1024, kt * 64, nt * 64, 512,
                     (u16*)(ws + OFF_WBR) + (size_t)mat * 1024 * 512, 0, nullptr, smem);
    } else if (it < E4) {
      const int q = it - E3, l = q / 256, r = q % 256, kt = r / 16, nt = r % 16;
      transpose_item(p.w_out + (size_t)l * 1024 * 1024, 1024, kt * 64, nt * 64, 1024,
                     (u16*)(ws + OFF_WOUT) + (size_t)l * 1024 * 1024, 0, nullptr, smem);
    } else if (it < E5) {
      const int q = it - E4, l = q / 48, n0 = (q % 48) * 64;
      float* sv = (float*)smem;
      float* red = sv + 5 * 1024;
      const int tid = opaque_tid();
      for (int i = tid; i < 5 * 1024; i += 512) {
        const int rr = i >> 10, k = i & 1023;
        const float v = (rr < 4) ? p.c[rr * 1024 + k] : p.c_ctx[k];
        sv[i] = v / (1.f + __expf(-v));
      }
      __syncthreads();
      const int cc = tid & 63, kg = tid >> 6;
      float a[5] = {0, 0, 0, 0, 0};
      const float* wp = p.w_ada + (size_t)l * 1024 * 3072 + n0 + cc;
#pragma unroll 4
      for (int k = kg * 128; k < kg * 128 + 128; ++k) {
        const float w = wp[(size_t)k * 3072];
#pragma unroll
        for (int rr = 0; rr < 5; ++rr) a[rr] += sv[rr * 1024 + k] * w;
      }
#pragma unroll
      for (int rr = 0; rr < 5; ++rr) red[(kg * 5 + rr) * 64 + cc] = a[rr];
      __syncthreads();
      if (tid < 320) {
        const int rr = tid >> 6, c2 = tid & 63;
        float s = 0;
#pragma unroll
        for (int g = 0; g < 8; ++g) s += red[(g * 5 + rr) * 64 + c2];
        s += p.b_ada[l * 3072 + n0 + c2];
        ((float*)(ws + OFF_MOD))[(l * 5 + rr) * 3072 + n0 + c2] = s;
      }
      __syncthreads();
    } else {
      const int tl = opaque_tid();
      if (tl < 2) {
        const int l = tl;
        float s1 = 0, s2 = 0;
        for (int i = 0; i < 64; ++i) {
          s1 += p.diff_lq1[l * 64 + i] * p.diff_lk1[l * 64 + i];
          s2 += p.diff_lq2[l * 64 + i] * p.diff_lk2[l * 64 + i];
        }
        const float lam_init = 0.8f - 0.6f * expf(-0.3f * (float)l);
        ((float*)(ws + OFF_LAM))[l] = expf(s1) - expf(s2) + lam_init;
        ((float*)(ws + OFF_LAM))[2 + l] = lam_init;
      }
    }
  }
}

DEV void phase_norm(const Params& p, int l) {
  char* ws = opaque_ptr(p.ws);
  const float* xs = l == 0 ? p.x : p.out;
  const float* cs = l == 0 ? p.ctx : (const float*)(ws + OFF_CTX1);
  const float* mod = (const float*)(ws + OFF_MOD) + (size_t)l * 5 * 3072;
  const float* g = p.norm_g + l * 1024;
  u16* H = (u16*)(ws + OFF_H);
  const int tid = opaque_tid(), lane = tid & 63;
  for (int m = blockIdx.x * 8 + (tid >> 6); m < MALL; m += gridDim.x * 8) {
    const int b = m / TP, tp = m - b * TP;
    const float* src = (tp < CTXL) ? cs + ((size_t)b * CTXL + tp) * DM : xs + ((size_t)b * SEQ + (tp - CTXL)) * DM;
    const float* md = mod + ((tp < CTXL) ? 4 : b) * 3072;
    float4 v[4];
    float ss = 0;
#pragma unroll
    for (int i = 0; i < 4; ++i) {
      v[i] = *(const float4*)(src + i * 256 + lane * 4);
      ss += v[i].x * v[i].x + v[i].y * v[i].y + v[i].z * v[i].z + v[i].w * v[i].w;
    }
#pragma unroll
    for (int o = 1; o < 64; o <<= 1) ss += __shfl_xor(ss, o, 64);
    const float rs = rsqrtf(ss * (1.f / 1024.f) + EPS);
#pragma unroll
    for (int i = 0; i < 4; ++i) {
      const int n = i * 256 + lane * 4;
      const float4 gg = *(const float4*)(g + n);
      const float4 sh = *(const float4*)(md + n);
      const float4 sc = *(const float4*)(md + 1024 + n);
      const float o0 = v[i].x * rs * gg.x * (1.f + sc.x) + sh.x;
      const float o1 = v[i].y * rs * gg.y * (1.f + sc.y) + sh.y;
      const float o2 = v[i].z * rs * gg.z * (1.f + sc.z) + sh.z;
      const float o3 = v[i].w * rs * gg.w * (1.f + sc.w) + sh.w;
      *(uint2*)(H + (size_t)(m >> 8) * (256 * 1024) + (size_t)(n >> 6) * (256 * 64) + (m & 255) * 64 + (n & 63)) = pk4(o0, o1, o2, o3);
    }
  }
}

DEV void inproj_epilogue(f32x16 (&acc)[2][2], int fb, int m0w, const Params& p, int l) {
  char* ws = opaque_ptr(p.ws);
  const int lane = opaque_tid() & 63, h = lane >> 5, r = lane & 31;
  if (fb == 35) return;
  const bool is_qk = (fb < 16) || (fb >= 36 && fb < 52);
  if (is_qk) {
    const float* gain;
    u16* dst;
    float qs = 1.f;
    bool rope = false;
    int head;
    if (fb < 8) { gain = p.na_q_g + l * 64; dst = (u16*)(ws + OFF_NAQ); head = fb; qs = 0.125f * LOG2E; }
    else if (fb < 16) { gain = p.na_k_g + l * 64; dst = (u16*)(ws + OFF_NAK); head = fb - 8; }
    else if (fb < 44) { gain = p.diff_q_g + l * 64; dst = (u16*)(ws + OFF_DQ); head = fb - 36; qs = 0.125f * LOG2E; rope = true; }
    else { gain = p.diff_k_g + l * 64; dst = (u16*)(ws + OFF_DK); head = fb - 44; rope = true; }
#pragma unroll
    for (int j = 0; j < 2; ++j) {
      const int m = m0w + 32 * j + r;
      const int bl = m / TP, tp = m - bl * TP;
      float ss = 0;
#pragma unroll
      for (int i = 0; i < 2; ++i)
#pragma unroll
        for (int e = 0; e < 16; ++e) ss += acc[i][j][e] * acc[i][j][e];
      ss += xor32(ss);
      const float rs = rsqrtf(ss * (1.f / 64.f) + EPS);
      u16* drow = dst + ((size_t)(bl * 8 + head) * TP + tp) * 64;
      const bool do_rope = rope && (tp >= CTXL);
      const int pos = tp - CTXL;
      const float prow = (float)(pos >> 6), pcol = (float)(pos & 63);
      float oa[16], ob[16];
#pragma unroll
      for (int g4 = 0; g4 < 4; ++g4) {
        const int f1 = 8 * g4 + 4 * h;
        const float4 ga = *(const float4*)(gain + f1);
        const float4 gb = *(const float4*)(gain + 32 + f1);
        float a[4], b[4];
        a[0] = acc[0][j][4 * g4 + 0] * rs * ga.x; a[1] = acc[0][j][4 * g4 + 1] * rs * ga.y;
        a[2] = acc[0][j][4 * g4 + 2] * rs * ga.z; a[3] = acc[0][j][4 * g4 + 3] * rs * ga.w;
        b[0] = acc[1][j][4 * g4 + 0] * rs * gb.x; b[1] = acc[1][j][4 * g4 + 1] * rs * gb.y;
        b[2] = acc[1][j][4 * g4 + 2] * rs * gb.z; b[3] = acc[1][j][4 * g4 + 3] * rs * gb.w;
        if (do_rope) {
#pragma unroll
          for (int e = 0; e < 4; ++e) {
            const int f = f1 + e;
            const float inv = fast_exp2(-(float)(f & 15) * 0.8304820237218406f);
            const float ang = ((f < 16) ? prow : pcol) * inv;
            float sn, cs;
            sincos_fast(ang, sn, cs);
            const float x1 = a[e], x2 = b[e];
            a[e] = x1 * cs - x2 * sn;
            b[e] = x2 * cs + x1 * sn;
          }
        }
#pragma unroll
        for (int e = 0; e < 4; ++e) { oa[4 * g4 + e] = a[e] * qs; ob[4 * g4 + e] = b[e] * qs; }
      }
      store_row32(drow, oa, h);
      store_row32(drow + 32, ob, h);
    }
    return;
  }
  if (fb == 34) {
    float* dst = (float*)(ws + OFF_KROPE);
#pragma unroll
    for (int j = 0; j < 2; ++j) {
      const int m = m0w + 32 * j + r;
#pragma unroll
      for (int g4 = 0; g4 < 4; ++g4)
        *(float4*)(dst + (size_t)m * 32 + 8 * g4 + 4 * h) =
            make_float4(acc[0][j][4 * g4], acc[0][j][4 * g4 + 1], acc[0][j][4 * g4 + 2], acc[0][j][4 * g4 + 3]);
    }
    return;
  }
  int mode = 0;
  int ssq_slot = -1;
  u16* dst;
  size_t pitch;
  int col0;
  bool headmajor = false;
  int hm_heads = 0, hm_head = 0, hm_w = 0;
  if (fb < 24) { headmajor = true; dst = (u16*)(ws + OFF_NAV); hm_heads = 8; hm_head = fb - 16; hm_w = 64; col0 = 0; pitch = 0; }
  else if (fb < 30) { dst = (u16*)(ws + OFF_CQ); pitch = 384; col0 = (fb - 24) * 64; ssq_slot = fb - 24; }
  else if (fb < 34) { dst = (u16*)(ws + OFF_CKV); pitch = 256; col0 = (fb - 30) * 64; ssq_slot = 6 + fb - 30; }
  else if (fb < 60) { headmajor = true; dst = (u16*)(ws + OFF_DV); hm_heads = 4; hm_head = (fb - 52) >> 1; hm_w = 128; col0 = ((fb - 52) & 1) * 64; pitch = 0; }
  else if (fb < 84) { dst = (u16*)(ws + OFF_Z); pitch = 1536; col0 = (fb - 60) * 64; mode = 1; }
  else { dst = (u16*)(ws + OFF_G); pitch = 3072; col0 = (fb - 84) * 64; mode = 2; }
#pragma unroll
  for (int j = 0; j < 2; ++j) {
    const int m = m0w + 32 * j + r;
    u16* drow;
    if (headmajor) {
      const int bl = m / TP, tp = m - bl * TP;
      drow = dst + ((size_t)(bl * hm_heads + hm_head) * TP + tp) * hm_w + col0;
    } else {
      drow = dst + (size_t)m * pitch + col0;
    }
    float ss = 0;
#pragma unroll
    for (int i = 0; i < 2; ++i) {
      float v[16];
#pragma unroll
      for (int e = 0; e < 16; ++e) {
        float t = acc[i][j][e];
        ss += t * t;
        if (mode == 1) t = siluf_(t);
        else if (mode == 2) t = sigmoidf_(t);
        v[e] = t;
      }
      store_row32(drow + 32 * i, v, h);
    }
    if (ssq_slot >= 0) {
      ss += xor32(ss);
      if (h == 0) ((float*)(ws + OFF_SSQ))[(size_t)m * 16 + ssq_slot] = ss;
    }
  }
}

DEV void phase_inproj(const Params& p, int l, int hf, char* smem) {
  char* ws = opaque_ptr(p.ws);
  const u16* H = (const u16*)(ws + OFF_H) + (size_t)hf * MH * 1024;
  const u16* W = (const u16*)(ws + OFF_WIN) + (size_t)l * NIN * 1024;
  const int w = opaque_tid() >> 6, wm = w >> 1, wn = w & 1;
  const int nslots = ((66 * 33 + 7) / 8) * 8;
  for (int t = blockIdx.x; t < nslots; t += gridDim.x) {
    int mt, nt;
    if (!tile_decode(t, 66, 33, 3, mt, nt)) continue;
    f32x16 acc[4][2];
#pragma unroll
    for (int i = 0; i < 4; ++i)
#pragma unroll
      for (int j = 0; j < 2; ++j)
#pragma unroll
        for (int e = 0; e < 16; ++e) acc[i][j][e] = 0.f;
    gemm_main<4, 2, 256, 2>(acc, H + (size_t)mt * 256 * 1024, 64, W + (size_t)nt * 256 * 1024, 64, 1024, smem, wm * 64, wn * 128, 256 * 64, 256 * 64);
    inproj_epilogue(*(f32x16(*)[2][2])&acc[0], nt * 4 + wn * 2, mt * 256 + wm * 64, p, l);
    inproj_epilogue(*(f32x16(*)[2][2])&acc[2], nt * 4 + wn * 2 + 1, mt * 256 + wm * 64, p, l);
  }
}

DEV void phase_upproj(const Params& p, int l, int hf, char* smem) {
  char* ws = opaque_ptr(p.ws);
  const int tid = opaque_tid(), w = tid >> 6, lane = tid & 63, h = lane >> 5, r = lane & 31;
  const int nslots = ((66 * 16 + 7) / 8) * 8;
  const float* ssq = (const float*)(ws + OFF_SSQ);
  for (int t = blockIdx.x; t < nslots; t += gridDim.x) {
    int mt, nt;
    if (!tile_decode(t, 66, 16, 2, mt, nt)) continue;
    f32x16 acc[4][1];
#pragma unroll
    for (int i = 0; i < 4; ++i)
#pragma unroll
      for (int e = 0; e < 16; ++e) acc[i][0][e] = 0.f;
    const int m = mt * 256 + w * 32 + r;
    const int bl = m / TP, tp = m - bl * TP;
    const bool latent = tp >= CTXL;
    const int pos = tp - CTXL;
    const float prow = (float)(pos >> 6), pcol = (float)(pos & 63);
    if (nt < 8) {
      const int hd = nt;
      float sqv[6];
      auto load_sq = [&]() {
        const float* sq = ssq + (size_t)m * 16;
#pragma unroll
        for (int i = 0; i < 6; ++i) sqv[i] = sq[i];
      };
      gemm_main<4, 1, 128, 3>(acc, (const u16*)(ws + OFF_CQ) + (size_t)mt * 256 * 384, 384,
                      (const u16*)(ws + OFF_WUQ) + ((size_t)l * 1024 + hd * 128) * 384, 384, 384, smem, w * 32, 0, 64, 64, load_sq);
      const float rcq = rsqrtf((sqv[0] + sqv[1] + sqv[2] + sqv[3] + sqv[4] + sqv[5]) * (1.f / 384.f) + EPS);
      float ss = 0;
#pragma unroll
      for (int i = 0; i < 3; ++i)
#pragma unroll
        for (int e = 0; e < 16; ++e) { acc[i][0][e] *= rcq; ss += acc[i][0][e] * acc[i][0][e]; }
      ss += xor32(ss);
      const float rs = rsqrtf(ss * (1.f / 96.f) + EPS);
      const float* gain = p.mla_q_g + l * 96;
      const float qs = 0.10206207261596577f * LOG2E;
      u16* drow = (u16*)(ws + OFF_MQ) + ((size_t)(bl * 8 + hd) * TP + tp) * 96;
#pragma unroll
      for (int i = 0; i < 3; ++i)
#pragma unroll
        for (int e = 0; e < 16; ++e) acc[i][0][e] *= rs * gain[32 * i + crow_of(e, h)];
      if (latent) {
#pragma unroll
        for (int e = 0; e < 8; ++e) {
          const int a = crow_of(e, h);
          const float inv = fast_exp2(-(float)(a & 7) * 1.6609640474436813f);
          const float ang = ((a < 8) ? prow : pcol) * inv;
          float sn, cs;
          sincos_fast(ang, sn, cs);
          const float x1 = acc[2][0][e], x2 = acc[2][0][e + 8];
          acc[2][0][e] = x1 * cs - x2 * sn;
          acc[2][0][e + 8] = x2 * cs + x1 * sn;
        }
      }
#pragma unroll
      for (int i = 0; i < 3; ++i) {
        float ov[16];
#pragma unroll
        for (int e = 0; e < 16; ++e) ov[e] = acc[i][0][e] * qs;
        store_row32(drow + 32 * i, ov, h);
      }
    } else {
      const int hd = nt - 8;
      float sqv[4];
      float kr[16];
      auto load_pre = [&]() {
        const float* sq = ssq + (size_t)m * 16 + 6;
#pragma unroll
        for (int i = 0; i < 4; ++i) sqv[i] = sq[i];
        const float* krp = (const float*)(ws + OFF_KROPE) + (size_t)m * 32;
#pragma unroll
        for (int g4 = 0; g4 < 4; ++g4) {
          const float4 v = *(const float4*)(krp + 8 * g4 + 4 * h);
          kr[4 * g4] = v.x; kr[4 * g4 + 1] = v.y; kr[4 * g4 + 2] = v.z; kr[4 * g4 + 3] = v.w;
        }
      };
      gemm_main<4, 1, 128, 3>(acc, (const u16*)(ws + OFF_CKV) + (size_t)mt * 256 * 256, 256,
                      (const u16*)(ws + OFF_WUKV) + ((size_t)l * 1024 + hd * 128) * 256, 256, 256, smem, w * 32, 0, 64, 64, load_pre);
      const float rckv = rsqrtf((sqv[0] + sqv[1] + sqv[2] + sqv[3]) * (1.f / 256.f) + EPS);
      float ss = 0;
#pragma unroll
      for (int i = 0; i < 4; ++i)
#pragma unroll
        for (int e = 0; e < 16; ++e) { acc[i][0][e] *= rckv; if (i < 2) ss += acc[i][0][e] * acc[i][0][e]; }
#pragma unroll
      for (int e = 0; e < 16; ++e) ss += kr[e] * kr[e];
      ss += xor32(ss);
      const float rs = rsqrtf(ss * (1.f / 96.f) + EPS);
      const float* gain = p.mla_k_g + l * 96;
      u16* krow = (u16*)(ws + OFF_MK) + ((size_t)(bl * 8 + hd) * TP + tp) * 96;
      u16* vrow = (u16*)(ws + OFF_MV) + ((size_t)(bl * 8 + hd) * TP + tp) * 64;
#pragma unroll
      for (int e = 0; e < 16; ++e) kr[e] *= rs * gain[64 + crow_of(e, h)];
      if (latent) {
#pragma unroll
        for (int e = 0; e < 8; ++e) {
          const int a = crow_of(e, h);
          const float inv = fast_exp2(-(float)(a & 7) * 1.6609640474436813f);
          const float ang = ((a < 8) ? prow : pcol) * inv;
          float sn, cs;
          sincos_fast(ang, sn, cs);
          const float x1 = kr[e], x2 = kr[e + 8];
          kr[e] = x1 * cs - x2 * sn;
          kr[e + 8] = x2 * cs + x1 * sn;
        }
      }
#pragma unroll
      for (int i = 0; i < 2; ++i) {
        float ov[16];
#pragma unroll
        for (int g4 = 0; g4 < 4; ++g4) {
          const int f = 32 * i + 8 * g4 + 4 * h;
          const float4 gg = *(const float4*)(gain + f);
          ov[4 * g4] = acc[i][0][4 * g4] * rs * gg.x; ov[4 * g4 + 1] = acc[i][0][4 * g4 + 1] * rs * gg.y;
          ov[4 * g4 + 2] = acc[i][0][4 * g4 + 2] * rs * gg.z; ov[4 * g4 + 3] = acc[i][0][4 * g4 + 3] * rs * gg.w;
        }
        store_row32(krow + 32 * i, ov, h);
      }
      store_row32(krow + 64, kr, h);
#pragma unroll
      for (int i = 2; i < 4; ++i) {
        float ov[16];
#pragma unroll
        for (int e = 0; e < 16; ++e) ov[e] = acc[i][0][e];
        store_row32(vrow + 32 * (i - 2), ov, h);
      }
    }
  }
}

struct FlashArgs {
  const u16 *Q0, *Q1;
  const u16 *K0, *K1;
  const u16* V;
  int q_t0;
  int n_tiles;
  int lt0;
  const float* rpb;
  int r0;
};

template <int DQK, int DV, int NKH, int MODE>
DEV void flash_unit(const FlashArgs& fa, char* smem, f32x16 (&oacc)[DV / 32], float& linv_out) {
  constexpr int NSTG = 4;
  constexpr int K64B = NKH * 8;
  constexpr int K32B = (DQK == 96) ? 4 : 0;
  constexpr int VB = DV / 8;
  constexpr int NBLK = K64B + K32B + VB;
  constexpr int STAGE = NBLK * 1024;
  constexpr int OFF_K32 = K64B * 1024;
  constexpr int OFF_V = (K64B + K32B) * 1024;
  constexpr int LPT = (NBLK + 7) / 8;
  constexpr int NS = DQK / 16;
  constexpr int NV = DV / 32;
  static_assert(LPT <= 4, "LPT");
  const int tid = opaque_tid(), w = tid >> 6, lane = tid & 63, h = lane >> 5, r = lane & 31;
  const int kh = (NKH == 2) ? (w >> 2) : 0;
  const int qsub = (NKH == 2) ? (w & 3) : w;
  float* rpbs = (float*)(smem + NSTG * STAGE);

  auto dma_src = [&](int i, long& stride) -> const char* {
    const int b = 8 * i + w;
    if (b < K64B) {
      const int k2 = b >> 3, q = (b & 7) * 64 + lane, row = q >> 3, c = (q & 7) ^ ((row >> 1) & 7);
      stride = 64 * DQK * 2;
      return (const char*)(k2 ? fa.K1 : fa.K0) + row * (DQK * 2) + c * 16;
    } else if (b < K64B + K32B) {
      const int q = (b - K64B) * 64 + lane, row = q >> 2, c = (q & 3) ^ ((row >> 2) & 3);
      stride = 64 * DQK * 2;
      return (const char*)fa.K0 + row * (DQK * 2) + 128 + c * 16;
    } else {
      const int q = (b - K64B - K32B) * 64 + lane;
      stride = 64 * DV * 2;
      if (DV == 64) {
        const int row = q >> 3, c = (q & 7) ^ ((row & 2) << 1);
        return (const char*)fa.V + row * 128 + c * 16;
      } else {
        const int row = q >> 4, c = (q & 15) ^ (((row & 3) << 2) | ((row >> 2) & 3));
        return (const char*)fa.V + row * 256 + c * 16;
      }
    }
  };
  long str0 = 0, str1 = 0, str2 = 0, str3 = 0;
  const char* src0 = dma_src(0, str0);
  const char* src1 = (LPT > 1) ? dma_src(1, str1) : nullptr;
  const char* src2 = (LPT > 2) ? dma_src(2, str2) : nullptr;
  const char* src3 = (LPT > 3) ? dma_src(3, str3) : nullptr;
  const int nld = (NBLK % 8 == 0) ? LPT : ((w < (NBLK % 8)) ? LPT : LPT - 1);
  auto tile_id = [&](int it) { return it < 4 ? it : it - 4 + fa.lt0; };
  char* lds_t = smem + w * 1024 + lane * 16;
  auto issue_piece = [&](int it, int pc) {
    const long t = tile_id(it);
    char* st = lds_t + (it & (NSTG - 1)) * STAGE;
    if (pc == 0)
      __builtin_amdgcn_global_load_lds((const unsigned*)(src0 + t * str0), (unsigned __attribute__((address_space(3)))*)(st), 16, 0, 0);
    if (pc == 1 && LPT > 1 && (LPT - 1 > 1 || nld > 1))
      __builtin_amdgcn_global_load_lds((const unsigned*)(src1 + t * str1), (unsigned __attribute__((address_space(3)))*)(st + 8192), 16, 0, 0);
    if (pc == 2 && LPT > 2 && (LPT - 1 > 2 || nld > 2))
      __builtin_amdgcn_global_load_lds((const unsigned*)(src2 + t * str2), (unsigned __attribute__((address_space(3)))*)(st + 16384), 16, 0, 0);
    if (pc == 3 && LPT > 3 && nld > 3)
      __builtin_amdgcn_global_load_lds((const unsigned*)(src3 + t * str3), (unsigned __attribute__((address_space(3)))*)(st + 24576), 16, 0, 0);
  };
  auto issue = [&](int it) {
#pragma unroll
    for (int pc = 0; pc < LPT; ++pc) issue_piece(it, pc);
  };

  bf16x8 qf[NS];
  {
    const u16* qp = (kh ? fa.Q1 : fa.Q0) + (size_t)(fa.q_t0 + qsub * 32 + r) * DQK + 8 * h;
#pragma unroll
    for (int s = 0; s < NS; ++s) qf[s] = *(const bf16x8*)(qp + 16 * s);
  }
  int na_row = 0, na_rs = 0, na_qc = 0, na_cstart = 0;
  if (MODE == 1) {
    na_row = fa.r0 + (w >> 1);
    na_rs = min(max(na_row - 4, 0), 120);
    na_qc = (w & 1) * 32 + r;
    na_cstart = min(max(na_qc - 8, 0), 48);
    for (int i = tid; i < 15 * 31; i += 512) rpbs[i] = fa.rpb[i] * LOG2E;
  }
#pragma unroll
  for (int v = 0; v < NV; ++v)
#pragma unroll
    for (int e = 0; e < 16; ++e) oacc[v][e] = 0.f;
  float mrun = 0.f;
  f32x16 negm;
#pragma unroll
  for (int e = 0; e < 16; ++e) negm[e] = 0.f;
  float lrun = 0.f;

  const int kx = (r >> 1) & 7;
  int kxo[4];
#pragma unroll
  for (int s = 0; s < 4; ++s) kxo[s] = (((2 * s + h) ^ kx) << 4);
  const int k32x = (r >> 2) & 3;
  const int blk = (lane >> 4) & 1, i16 = lane & 15, q4 = i16 >> 2, p4 = i16 & 3;
  int vlow0, vlow1, vhi[NV];
  if (DV == 64) {
    vlow0 = (4 * h + q4) * 128 + (blk * 2 + (p4 >> 1)) * 16 + (p4 & 1) * 8;
    vlow1 = vlow0;
#pragma unroll
    for (int v = 0; v < NV; ++v) vhi[v] = ((v ^ ((q4 >> 1) & 1)) * 64);
  } else {
    vlow0 = (4 * h + q4) * 256 + (((blk * 2 + (p4 >> 1)) ^ (h)) * 16) + (p4 & 1) * 8;
    vlow1 = (4 * h + q4) * 256 + (((blk * 2 + (p4 >> 1)) ^ (2 + h)) * 16) + (p4 & 1) * 8;
#pragma unroll
    for (int v = 0; v < NV; ++v) vhi[v] = ((v ^ q4) * 64);
  }
  constexpr int VROW = DV * 2;

  asm volatile("s_waitcnt vmcnt(0)" ::: "memory");
  issue(0);
  issue(1);
  issue(2);

  for (int it = 0; it < fa.n_tiles; ++it) {
    {
      const int newer = min(2, fa.n_tiles - 1 - it) * nld;
      if (newer >= 8) asm volatile("s_waitcnt vmcnt(8)" ::: "memory");
      else if (newer == 6) asm volatile("s_waitcnt vmcnt(6)" ::: "memory");
      else if (newer == 4) asm volatile("s_waitcnt vmcnt(4)" ::: "memory");
      else if (newer == 3) asm volatile("s_waitcnt vmcnt(3)" ::: "memory");
      else if (newer == 2) asm volatile("s_waitcnt vmcnt(2)" ::: "memory");
      else asm volatile("s_waitcnt vmcnt(0)" ::: "memory");
    }
    __builtin_amdgcn_s_barrier();
    const bool pre = (it + 3 < fa.n_tiles);
    bool active = true;
    int krow = 0;
    if (MODE == 1 && it >= 4) {
      krow = tile_id(it) - 4;
      active = (krow >= na_rs) && (krow < na_rs + 8);
    }
    if (active) {
      const char* sb = smem + (it & (NSTG - 1)) * STAGE;
      const char* kb = sb + kh * 8192 + r * 128;
      const char* kb32 = sb + OFF_K32 + r * 64;
      const char* vb = sb + OFF_V;
      f32x16 st[2];
      bf16x8 kfr[2][NS];
#pragma unroll
      for (int k2 = 0; k2 < 2; ++k2)
#pragma unroll
        for (int s = 0; s < NS; ++s) {
          if (s < 4) kfr[k2][s] = *(const bf16x8*)(kb + k2 * 32 * 128 + kxo[s]);
          else kfr[k2][s] = *(const bf16x8*)(kb32 + k2 * 32 * 64 + (((2 * (s - 4) + h) ^ k32x) << 4));
        }
      __builtin_amdgcn_sched_barrier(0);
#pragma unroll
      for (int k2 = 0; k2 < 2; ++k2) {
#pragma unroll
        for (int s = 0; s < NS; ++s) {
          const bf16x8 kf = kfr[k2][s];
          if (s == 0) st[k2] = MFMA(kf, qf[s], negm);
          else st[k2] = MFMA(kf, qf[s], st[k2]);
          constexpr int NQK = 2 * NS, EVERY = NQK / LPT;
          const int m = k2 * NS + s;
          if ((m + 1) % EVERY == 0 && (m + 1) / EVERY <= LPT) {
            __builtin_amdgcn_sched_barrier(0);
            if (pre) issue_piece(it + 3, (m + 1) / EVERY - 1);
            __builtin_amdgcn_sched_barrier(0);
          }
        }
      }
      if (MODE == 1 && it >= 4) {
        const int dr = krow - na_row + 7;
        const float* bp = rpbs + dr * 31;
#pragma unroll
        for (int k2 = 0; k2 < 2; ++k2)
#pragma unroll
          for (int e = 0; e < 16; ++e) {
            const int kc = k2 * 32 + crow_of(e, h);
            const bool valid = (kc >= na_cstart) && (kc < na_cstart + 16);
            const int idx = min(max(kc - na_qc + 15, 0), 30);
            const float bv = bp[idx];
            st[k2][e] = valid ? st[k2][e] + bv : -1e30f;
          }
      }
      float rel = st[0][0];
#pragma unroll
      for (int e = 1; e < 16; ++e) rel = fmaxf(rel, st[0][e]);
#pragma unroll
      for (int e = 0; e < 16; ++e) rel = fmaxf(rel, st[1][e]);
      rel = half_max(rel);
      const bool first = (it == 0);
      if (first || __builtin_amdgcn_ballot_w64(rel > 8.f) != 0) {
        const float d = first ? rel : fmaxf(rel, 0.f);
        const float alpha = fast_exp2(-d);
        mrun += d;
#pragma unroll
        for (int k2 = 0; k2 < 2; ++k2)
#pragma unroll
          for (int e = 0; e < 16; ++e) st[k2][e] -= d;
#pragma unroll
        for (int v = 0; v < NV; ++v)
#pragma unroll
          for (int e = 0; e < 16; ++e) oacc[v][e] *= alpha;
#pragma unroll
        for (int e = 0; e < 16; ++e) negm[e] = -mrun;
        lrun *= alpha;
      }
      float psum = 0.f;
#pragma unroll
      for (int k2 = 0; k2 < 2; ++k2)
#pragma unroll
        for (int e = 0; e < 16; ++e) { st[k2][e] = fast_exp2(st[k2][e]); psum += st[k2][e]; }
      lrun += psum;
      bf16x8 pf[2][2];
#pragma unroll
      for (int k2 = 0; k2 < 2; ++k2)
#pragma unroll
        for (int s2 = 0; s2 < 2; ++s2) {
          uint4 u = make_uint4(pk2(st[k2][8 * s2], st[k2][8 * s2 + 1]), pk2(st[k2][8 * s2 + 2], st[k2][8 * s2 + 3]),
                               pk2(st[k2][8 * s2 + 4], st[k2][8 * s2 + 5]), pk2(st[k2][8 * s2 + 6], st[k2][8 * s2 + 7]));
          pf[k2][s2] = __builtin_bit_cast(bf16x8, u);
        }
#pragma unroll
      for (int v = 0; v < NV; ++v)
#pragma unroll
        for (int k2 = 0; k2 < 2; ++k2)
#pragma unroll
          for (int s2 = 0; s2 < 2; ++s2) {
            const char* a1 = vb + (k2 * 32 + s2 * 16) * VROW + vhi[v] + vlow0;
            const char* a2 = vb + (k2 * 32 + s2 * 16 + 8) * VROW + vhi[v] + vlow1;
            s16x4 lo = __builtin_amdgcn_ds_read_tr16_b64_v4i16((__attribute__((address_space(3))) s16x4*)(a1));
            s16x4 hi = __builtin_amdgcn_ds_read_tr16_b64_v4i16((__attribute__((address_space(3))) s16x4*)(a2));
            const bf16x8 vf = __builtin_shufflevector(lo, hi, 0, 1, 2, 3, 4, 5, 6, 7);
            oacc[v] = MFMA(vf, pf[k2][s2], oacc[v]);
          }
    } else {
      if (pre) issue(it + 3);
    }
  }
  __builtin_amdgcn_s_barrier();
  linv_out = fast_rcp(lrun + xor32(lrun));
}

template <int NV>
DEV void attn_store(f32x16 (&o)[NV], float scale_lane, const u16* zrow, u16* arow, const float* vgain  ) {
  const int lane = opaque_tid() & 63, h = lane >> 5;
#pragma unroll
  for (int v = 0; v < NV; ++v) {
    float ov[16];
#pragma unroll
    for (int g4 = 0; g4 < 4; ++g4) {
      const int f = 32 * v + 8 * g4 + 4 * h;
      const uint2 zz = *(const uint2*)(zrow + f);
      float z0 = __uint_as_float(zz.x << 16), z1 = __uint_as_float(zz.x & 0xffff0000u);
      float z2 = __uint_as_float(zz.y << 16), z3 = __uint_as_float(zz.y & 0xffff0000u);
      float a0 = o[v][4 * g4] * scale_lane, a1 = o[v][4 * g4 + 1] * scale_lane, a2 = o[v][4 * g4 + 2] * scale_lane,
            a3 = o[v][4 * g4 + 3] * scale_lane;
      if (vgain) {
        const float4 gg = *(const float4*)(vgain + f);
        a0 *= gg.x; a1 *= gg.y; a2 *= gg.z; a3 *= gg.w;
      }
      ov[4 * g4] = a0 * z0; ov[4 * g4 + 1] = a1 * z1; ov[4 * g4 + 2] = a2 * z2; ov[4 * g4 + 3] = a3 * z3;
    }
    store_row32(arow + 32 * v, ov, h);
  }
}

DEV void attn_diff_unit(const Params& p, int l, int bl, int hd, int q_t0, int n_tiles, char* smem) {
  char* ws = opaque_ptr(p.ws);
  const int tid = opaque_tid(), w = tid >> 6, lane = tid & 63, r = lane & 31;
  const float lam = ((const float*)(ws + OFF_LAM))[l];
  const float lam_init = ((const float*)(ws + OFF_LAM))[2 + l];
  FlashArgs fa;
  fa.rpb = nullptr; fa.r0 = 0; fa.lt0 = 4; fa.n_tiles = n_tiles; fa.q_t0 = q_t0;
  fa.Q0 = (const u16*)(ws + OFF_DQ) + (size_t)(bl * 8 + hd * 2) * TP * 64;
  fa.Q1 = fa.Q0 + (size_t)TP * 64;
  fa.K0 = (const u16*)(ws + OFF_DK) + (size_t)(bl * 8 + hd * 2) * TP * 64;
  fa.K1 = fa.K0 + (size_t)TP * 64;
  fa.V = (const u16*)(ws + OFF_DV) + (size_t)(bl * 4 + hd) * TP * 128;
  f32x16 o[4];
  float linv;
  flash_unit<64, 128, 2, 0>(fa, smem, o, linv);
  float* xb = (float*)smem;
  if (w >= 4) {
#pragma unroll
    for (int v = 0; v < 4; ++v)
#pragma unroll
      for (int e = 0; e < 16; ++e) xb[((w - 4) * 64 + v * 16 + e) * 64 + lane] = o[v][e] * linv;
  }
  __syncthreads();
  if (w < 4) {
    float ss = 0;
#pragma unroll
    for (int v = 0; v < 4; ++v)
#pragma unroll
      for (int e = 0; e < 16; ++e) {
        const float t = o[v][e] * linv - lam * xb[(w * 64 + v * 16 + e) * 64 + lane];
        o[v][e] = t;
        ss += t * t;
      }
    ss += xor32(ss);
    const float rs = rsqrtf(ss * (1.f / 128.f) + EPS) * (1.f - lam_init);
    const int tp = q_t0 + w * 32 + r;
    const size_t m = (size_t)bl * TP + tp;
    attn_store<4>(o, rs, (const u16*)(ws + OFF_Z) + m * 1536 + 1024 + hd * 128, (u16*)(ws + OFF_ACAT) + m * 1536 + 1024 + hd * 128,
                  p.diff_subln_g + l * 128);
  }
  __syncthreads();
}

DEV void attn_mla_unit(const Params& p, int bl, int hd, int q_t0, int n_tiles, char* smem) {
  char* ws = opaque_ptr(p.ws);
  const int tid = opaque_tid(), w = tid >> 6, lane = tid & 63, r = lane & 31;
  FlashArgs fa;
  fa.rpb = nullptr; fa.r0 = 0; fa.lt0 = 4; fa.n_tiles = n_tiles; fa.q_t0 = q_t0;
  fa.Q0 = (const u16*)(ws + OFF_MQ) + (size_t)(bl * 8 + hd) * TP * 96; fa.Q1 = fa.Q0;
  fa.K0 = (const u16*)(ws + OFF_MK) + (size_t)(bl * 8 + hd) * TP * 96; fa.K1 = fa.K0;
  fa.V = (const u16*)(ws + OFF_MV) + (size_t)(bl * 8 + hd) * TP * 64;
  f32x16 o[2];
  float linv;
  flash_unit<96, 64, 1, 0>(fa, smem, o, linv);
  const int tp = q_t0 + w * 32 + r;
  const size_t m = (size_t)bl * TP + tp;
  attn_store<2>(o, linv, (const u16*)(ws + OFF_Z) + m * 1536 + 512 + hd * 64, (u16*)(ws + OFF_ACAT) + m * 1536 + 512 + hd * 64, nullptr);
}

DEV void attn_na_unit(const Params& p, int l, int bl, int hd, int qb, char* smem) {
  char* ws = opaque_ptr(p.ws);
  const int tid = opaque_tid(), w = tid >> 6, lane = tid & 63, r = lane & 31;
  FlashArgs fa;
  fa.Q0 = (const u16*)(ws + OFF_NAQ) + (size_t)(bl * 8 + hd) * TP * 64; fa.Q1 = fa.Q0;
  fa.K0 = (const u16*)(ws + OFF_NAK) + (size_t)(bl * 8 + hd) * TP * 64; fa.K1 = fa.K0;
  fa.V = (const u16*)(ws + OFF_NAV) + (size_t)(bl * 8 + hd) * TP * 64;
  fa.rpb = p.na_rpb + ((size_t)l * 8 + hd) * 15 * 31;
  f32x16 o[2];
  float linv;
  if (qb >= 0) {
    const int r0 = qb * 4;
    const int rlo = min(max(r0 - 4, 0), 120);
    const int rhi = min(max(r0 + 3 - 4, 0), 120) + 8;
    fa.q_t0 = CTXL + r0 * 64;
    fa.r0 = r0;
    fa.lt0 = 4 + rlo;
    fa.n_tiles = 4 + (rhi - rlo);
  } else {
    fa.q_t0 = 0; fa.r0 = 0; fa.lt0 = 4; fa.n_tiles = 4;
  }
  flash_unit<64, 64, 1, 1>(fa, smem, o, linv);
  const int tp = fa.q_t0 + w * 32 + r;
  const size_t m = (size_t)bl * TP + tp;
  attn_store<2>(o, linv, (const u16*)(ws + OFF_Z) + m * 1536 + hd * 64, (u16*)(ws + OFF_ACAT) + m * 1536 + hd * 64, nullptr);
}

DEV void phase_attn(const Params& p, int l, int hf, char* smem) {
  const int nctx = (l == 0) ? 16 : 0;
  for (int rep = 0; rep < REP_DIFF; ++rep)
  for (int u = blockIdx.x; u < 512 + nctx; u += gridDim.x) {
    int pair, q_t0, nt;
    if (u < 512) { pair = u & 7; q_t0 = CTXL + (u >> 3) * 128; nt = 132; }
    else { const int v = u - 512; pair = v >> 1; q_t0 = (v & 1) * 128; nt = 4; }
    attn_diff_unit(p, l, pair >> 2, pair & 3, q_t0, nt, smem);
  }
  for (int rep = 0; rep < REP_MLA; ++rep)
  for (int u = blockIdx.x; u < 512 + 2 * nctx; u += gridDim.x) {
    int pair, q_t0, nt;
    if (u < 512) { pair = (u & 7) + 8 * (u >> 8); q_t0 = CTXL + ((u >> 3) & 31) * 256; nt = 132; }
    else { pair = u - 512 - nctx; q_t0 = 0; nt = 4; if (pair < 0) continue; }
    attn_mla_unit(p, pair >> 3, pair & 7, q_t0, nt, smem);
  }
  for (int rep = 0; rep < REP_NA; ++rep)
  for (int u = blockIdx.x; u < 512 + 3 * nctx; u += gridDim.x) {
    int pair, qb;
    if (u < 512) { pair = (u & 7) + 8 * (u >> 8); qb = (u >> 3) & 31; }
    else { pair = u - 512 - 2 * nctx; qb = -1; if (pair < 0) continue; }
    attn_na_unit(p, l, pair >> 3, pair & 7, qb, smem);
  }
}

DEV void phase_merge(const Params& p, int l, int hf, char* smem) {
  char* ws = opaque_ptr(p.ws);
  const int tid = opaque_tid(), w = tid >> 6, wm = w >> 1, wn = w & 1, lane = tid & 63, h = lane >> 5, r = lane & 31;
  const u16* A = (const u16*)(ws + OFF_ACAT);
  const u16* G = (const u16*)(ws + OFF_G);
  u16* Y = (u16*)(ws + OFF_H) + (size_t)hf * MH * 1024;
  const int nslots = 64 * 8;
  for (int t = blockIdx.x; t < nslots; t += gridDim.x) {
    int mq, nt;
    if (!tile_decode(t, 64, 8, 4, mq, nt)) continue;
    const int mt = (mq >> 5) * 33 + 1 + (mq & 31);
    f32x16 yacc[2][2];
#pragma unroll
    for (int i = 0; i < 2; ++i)
#pragma unroll
      for (int j = 0; j < 2; ++j)
#pragma unroll
        for (int e = 0; e < 16; ++e) yacc[i][j][e] = 0.f;
#pragma unroll 1
    for (int br = 0; br < 3; ++br) {
      f32x16 acc[2][2];
#pragma unroll
      for (int i = 0; i < 2; ++i)
#pragma unroll
        for (int j = 0; j < 2; ++j)
#pragma unroll
          for (int e = 0; e < 16; ++e) acc[i][j][e] = 0.f;
      uint2 gpre[2][2][4];
      auto load_gates = [&]() {
#pragma unroll
        for (int j = 0; j < 2; ++j) {
          const size_t m = (size_t)mt * 256 + wm * 64 + 32 * j + r;
          const u16* grow = G + m * 3072 + br * 1024 + nt * 128 + wn * 64;
#pragma unroll
          for (int i = 0; i < 2; ++i)
#pragma unroll
            for (int g4 = 0; g4 < 4; ++g4) gpre[i][j][g4] = *(const uint2*)(grow + 32 * i + 8 * g4 + 4 * h);
        }
      };
      gemm_main<2, 2, 128, 3>(acc, A + (size_t)mt * 256 * 1536 + br * 512, 1536,
                              (const u16*)(ws + OFF_WBR) + ((size_t)(l * 3 + br) * 1024 + nt * 128) * 512, 512, 512, smem, wm * 64,
                              wn * 64, 64, 64, load_gates);
#pragma unroll
      for (int j = 0; j < 2; ++j) {
#pragma unroll
        for (int i = 0; i < 2; ++i)
#pragma unroll
          for (int g4 = 0; g4 < 4; ++g4) {
            const uint2 gg = gpre[i][j][g4];
            yacc[i][j][4 * g4] += acc[i][j][4 * g4] * __uint_as_float(gg.x << 16);
            yacc[i][j][4 * g4 + 1] += acc[i][j][4 * g4 + 1] * __uint_as_float(gg.x & 0xffff0000u);
            yacc[i][j][4 * g4 + 2] += acc[i][j][4 * g4 + 2] * __uint_as_float(gg.y << 16);
            yacc[i][j][4 * g4 + 3] += acc[i][j][4 * g4 + 3] * __uint_as_float(gg.y & 0xffff0000u);
          }
      }
    }
#pragma unroll
    for (int j = 0; j < 2; ++j) {
      const size_t m = (size_t)mt * 256 + wm * 64 + 32 * j + r;
      u16* yrow = Y + m * 1024 + nt * 128 + wn * 64;
#pragma unroll
      for (int i = 0; i < 2; ++i) {
        float v[16];
#pragma unroll
        for (int e = 0; e < 16; ++e) v[e] = yacc[i][j][e];
        store_row32(yrow + 32 * i, v, h);
      }
    }
  }
  if (l == 0) {
    for (int u = (int)gridDim.x - 1 - (int)blockIdx.x; u < 32; u += gridDim.x) {
      const int mt = (u >> 4) * 33, nt64 = u & 15;
      f32x16 yacc[1][2];
#pragma unroll
      for (int j = 0; j < 2; ++j)
#pragma unroll
        for (int e = 0; e < 16; ++e) yacc[0][j][e] = 0.f;
#pragma unroll 1
      for (int br = 0; br < 3; ++br) {
        f32x16 acc[1][2];
#pragma unroll
        for (int j = 0; j < 2; ++j)
#pragma unroll
          for (int e = 0; e < 16; ++e) acc[0][j][e] = 0.f;
        uint2 gpre[2][4];
        auto load_gates = [&]() {
#pragma unroll
          for (int j = 0; j < 2; ++j) {
            const size_t m = (size_t)mt * 256 + wm * 64 + 32 * j + r;
            const u16* grow = G + m * 3072 + br * 1024 + nt64 * 64 + wn * 32;
#pragma unroll
            for (int g4 = 0; g4 < 4; ++g4) gpre[j][g4] = *(const uint2*)(grow + 8 * g4 + 4 * h);
          }
        };
        gemm_main<1, 2, 64, 3>(acc, A + (size_t)mt * 256 * 1536 + br * 512, 1536,
                               (const u16*)(ws + OFF_WBR) + ((size_t)(l * 3 + br) * 1024 + nt64 * 64) * 512, 512, 512, smem, wm * 64,
                               wn * 32, 64, 64, load_gates);
#pragma unroll
        for (int j = 0; j < 2; ++j)
#pragma unroll
          for (int g4 = 0; g4 < 4; ++g4) {
            const uint2 gg = gpre[j][g4];
            yacc[0][j][4 * g4] += acc[0][j][4 * g4] * __uint_as_float(gg.x << 16);
            yacc[0][j][4 * g4 + 1] += acc[0][j][4 * g4 + 1] * __uint_as_float(gg.x & 0xffff0000u);
            yacc[0][j][4 * g4 + 2] += acc[0][j][4 * g4 + 2] * __uint_as_float(gg.y << 16);
            yacc[0][j][4 * g4 + 3] += acc[0][j][4 * g4 + 3] * __uint_as_float(gg.y & 0xffff0000u);
          }
      }
#pragma unroll
      for (int j = 0; j < 2; ++j) {
        const size_t m = (size_t)mt * 256 + wm * 64 + 32 * j + r;
        float v[16];
#pragma unroll
        for (int e = 0; e < 16; ++e) v[e] = yacc[0][j][e];
        store_row32(Y + m * 1024 + nt64 * 64 + wn * 32, v, h);
      }
    }
  }
}

DEV void phase_outproj(const Params& p, int l, int hf, char* smem) {
  char* ws = opaque_ptr(p.ws);
  const int tid = opaque_tid(), w = tid >> 6, wm = w >> 1, wn = w & 1, lane = tid & 63, h = lane >> 5, r = lane & 31;
  const u16* Y = (const u16*)(ws + OFF_H) + (size_t)hf * MH * 1024;
  const u16* W = (const u16*)(ws + OFF_WOUT) + (size_t)l * 1024 * 1024;
  const float* mod = (const float*)(ws + OFF_MOD) + (size_t)l * 5 * 3072;
  const float* xs = l == 0 ? p.x : p.out;
  const int nslots = 64 * 8;
  for (int t = blockIdx.x; t < nslots; t += gridDim.x) {
    int mq, nt;
    if (!tile_decode(t, 64, 8, 4, mq, nt)) continue;
    const int mt = (mq >> 5) * 33 + 1 + (mq & 31);
    f32x16 acc[2][2];
#pragma unroll
    for (int i = 0; i < 2; ++i)
#pragma unroll
      for (int j = 0; j < 2; ++j)
#pragma unroll
        for (int e = 0; e < 16; ++e) acc[i][j][e] = 0.f;
    float4 xpre[2][2][4];
    auto load_x = [&]() {
#pragma unroll
      for (int j = 0; j < 2; ++j) {
        const int m = mt * 256 + wm * 64 + 32 * j + r;
        const int bl = m / TP, tp = m - bl * TP;
        const int b = hf * 2 + bl;
        const float* src = (tp < CTXL) ? p.ctx + ((size_t)b * CTXL + tp) * DM : xs + ((size_t)b * SEQ + (tp - CTXL)) * DM;
#pragma unroll
        for (int i = 0; i < 2; ++i)
#pragma unroll
          for (int g4 = 0; g4 < 4; ++g4) xpre[i][j][g4] = *(const float4*)(src + nt * 128 + wn * 64 + 32 * i + 8 * g4 + 4 * h);
      }
    };
    gemm_main<2, 2, 128, 3>(acc, Y + (size_t)mt * 256 * 1024, 1024, W + (size_t)nt * 128 * 1024, 1024, 1024, smem, wm * 64, wn * 64,
                            64, 64, load_x);
#pragma unroll
    for (int j = 0; j < 2; ++j) {
      const int m = mt * 256 + wm * 64 + 32 * j + r;
      const int bl = m / TP, tp = m - bl * TP;
      const int b = hf * 2 + bl;
      const int n0 = nt * 128 + wn * 64;
      const float* src;
      float* dst;
      const float* gate;
      if (tp < CTXL) {
        src = p.ctx + ((size_t)b * CTXL + tp) * DM;
        dst = (float*)(ws + OFF_CTX1) + ((size_t)b * CTXL + tp) * DM;
        gate = mod + 4 * 3072 + 2048;
      } else {
        src = xs + ((size_t)b * SEQ + (tp - CTXL)) * DM;
        dst = p.out + ((size_t)b * SEQ + (tp - CTXL)) * DM;
        gate = mod + b * 3072 + 2048;
      }
#pragma unroll
      for (int i = 0; i < 2; ++i)
#pragma unroll
        for (int g4 = 0; g4 < 4; ++g4) {
          const int n = n0 + 32 * i + 8 * g4 + 4 * h;
          const float4 xv = xpre[i][j][g4];
          const float4 gv = *(const float4*)(gate + n);
          float4 o;
          o.x = xv.x + gv.x * acc[i][j][4 * g4];
          o.y = xv.y + gv.y * acc[i][j][4 * g4 + 1];
          o.z = xv.z + gv.z * acc[i][j][4 * g4 + 2];
          o.w = xv.w + gv.w * acc[i][j][4 * g4 + 3];
          *(float4*)(dst + n) = o;
        }
    }
  }
  if (l == 0) {
    for (int u = (int)gridDim.x - 1 - (int)blockIdx.x; u < 32; u += gridDim.x) {
      const int mt = (u >> 4) * 33, nt64 = u & 15;
      f32x16 acc[1][2];
#pragma unroll
      for (int j = 0; j < 2; ++j)
#pragma unroll
        for (int e = 0; e < 16; ++e) acc[0][j][e] = 0.f;
      gemm_main<1, 2, 64, 3>(acc, Y + (size_t)mt * 256 * 1024, 1024, W + (size_t)nt64 * 64 * 1024, 1024, 1024, smem, wm * 64, wn * 32);
      const float* gate = mod + 4 * 3072 + 2048;
#pragma unroll
      for (int j = 0; j < 2; ++j) {
        const int m = mt * 256 + wm * 64 + 32 * j + r;
        const int bl = m / TP, tp = m - bl * TP;
        float* dst = (float*)(ws + OFF_CTX1) + ((size_t)(hf * 2 + bl) * CTXL + tp) * DM;
#pragma unroll
        for (int g4 = 0; g4 < 4; ++g4) {
          const int n = nt64 * 64 + wn * 32 + 8 * g4 + 4 * h;
          const float4 xv = *(const float4*)(p.ctx + ((size_t)(hf * 2 + bl) * CTXL + tp) * DM + n);
          const float4 gv = *(const float4*)(gate + n);
          float4 o;
          o.x = xv.x + gv.x * acc[0][j][4 * g4];
          o.y = xv.y + gv.y * acc[0][j][4 * g4 + 1];
          o.z = xv.z + gv.z * acc[0][j][4 * g4 + 2];
          o.w = xv.w + gv.w * acc[0][j][4 * g4 + 3];
          *(float4*)(dst + n) = o;
        }
      }
    }
  }
}

#define XB_TMO      128
#define XB_XCNT(j)  (256  + 64 * (j))
#define XB_XSUB(j)  (1280 + 64 * (j))
#define XB_XGEN(j)  (2304 + 64 * (j))
#define XB_TOP      3328
#define XB_TOPGEN   3392
#define XB_SPIN_CAP (1u << 18)
#define LAS __attribute__((address_space(3)))
DEV unsigned xb_ld(unsigned* p) { return __hip_atomic_load(p, __ATOMIC_RELAXED, __HIP_MEMORY_SCOPE_AGENT); }
DEV unsigned xb_add(unsigned* p, unsigned v) { return __hip_atomic_fetch_add(p, v, __ATOMIC_RELAXED, __HIP_MEMORY_SCOPE_AGENT); }
DEV unsigned xb_xcc_id() { return (unsigned)__builtin_amdgcn_s_getreg((3 << 11) | 20) & 0xFu; }
#define XB_SPIN(cond, bar) do { unsigned _sp = 0; while (cond) { __builtin_amdgcn_s_sleep(1); \
    if ((++_sp & 255u) == 0u) { if (xb_ld(&(bar)[XB_TMO])) break; if (_sp > XB_SPIN_CAP) { atomicAdd(&(bar)[XB_TMO], 1u); break; } } } } while (0)
DEV void xcd_barrier_complete(unsigned* bar, unsigned x, unsigned& nloc, unsigned& nx) {
  const unsigned G = gridDim.x;
  unsigned sum, cnt, mine, sp = 0u;
  for (;;) {
    sum = 0u; cnt = 0u; mine = 0u;
#pragma unroll
    for (unsigned j = 0; j < 16; ++j) { const unsigned c = xb_ld(&bar[XB_XCNT(j)]); sum += c; cnt += (c > 0u) ? 1u : 0u; mine = (j == x) ? c : mine; }
    if (sum == G) break;
    __builtin_amdgcn_s_sleep(1);
    if ((++sp & 255u) == 0u) { if (xb_ld(&bar[XB_TMO])) break; if (sp > XB_SPIN_CAP) { atomicAdd(&bar[XB_TMO], 1u); break; } }
  }
  nloc = mine > 0u ? mine : 1u; nx = cnt > 0u ? cnt : 1u;
}
DEV void xcd_barrier(unsigned* bar, unsigned x, volatile LAS unsigned* st) {
  asm volatile("s_waitcnt vmcnt(0)" ::: "memory");
  __syncthreads();
  if (threadIdx.x == 0) {
    __builtin_amdgcn_s_waitcnt(0);
    unsigned nloc = st[0], nx = st[1];
    if (nloc == 0u) { xcd_barrier_complete(bar, x, nloc, nx); st[0] = nloc; st[1] = nx; }
    const unsigned old = xb_add(&bar[XB_XSUB(x)], 1u);
    const unsigned gen = old / nloc;
    if (old + 1u == (gen + 1u) * nloc) {
      __builtin_amdgcn_fence(__ATOMIC_RELEASE, "agent");
      asm volatile("s_waitcnt vmcnt(0)" ::: "memory");
      const unsigned og = xb_add(&bar[XB_TOP], 1u);
      const unsigned tg = og / nx;
      if (og + 1u == (tg + 1u) * nx) xb_add(&bar[XB_TOPGEN], 1u);
      else XB_SPIN(xb_ld(&bar[XB_TOPGEN]) == tg, bar);
      __builtin_amdgcn_fence(__ATOMIC_ACQUIRE, "agent");
      xb_add(&bar[XB_XGEN(x)], 1u);
      asm volatile("s_waitcnt vmcnt(0)" ::: "memory");
    } else {
      XB_SPIN(xb_ld(&bar[XB_XGEN(x)]) == gen, bar);
      __builtin_amdgcn_fence(__ATOMIC_ACQUIRE, "agent");
      asm volatile("s_waitcnt vmcnt(0)" ::: "memory");
    }
  }
  __syncthreads();
}

constexpr int N_PHASES = 23;
DEV void run_phase(const Params& p, int ph, char* smem) {
  if (ph == 0) { phase_prologue(p, smem); return; }
  const int q = ph - 1, l = q / 11, r = q % 11;
  if (r == 0) { phase_norm(p, l); return; }
  const int hf = (r - 1) / 5, k = (r - 1) % 5;
  switch (k) {
    case 0: for (int rep = 0; rep < REP_INPROJ; ++rep) phase_inproj(p, l, hf, smem); break;
    case 1: phase_upproj(p, l, hf, smem); break;
    case 2: phase_attn(p, l, hf, smem); break;
    case 3: phase_merge(p, l, hf, smem); break;
    default: phase_outproj(p, l, hf, smem); break;
  }
}

__global__ void __launch_bounds__(512) mega_kernel(Params p, int ph_begin, int ph_end) {
  extern __shared__ __attribute__((aligned(16))) char smem[];
  volatile LAS unsigned* st = (volatile LAS unsigned*)(smem + SMEM_BYTES);
  unsigned* bar = (unsigned*)(p.ws + OFF_BAR);
  if (threadIdx.x < 2) st[threadIdx.x] = 0u;
  __syncthreads();
  const unsigned xcc = xb_xcc_id();
  if (threadIdx.x == 0) (void)xb_add(&bar[XB_XCNT(xcc)], 1u);
  for (int ph = ph_begin; ph < ph_end; ++ph) {
    run_phase(p, ph, smem);
    if (ph + 1 < ph_end) {
      if (ph == ph_begin) cg::this_grid().sync();
      else xcd_barrier(bar, xcc, st);
    }
  }
}

extern "C" void kernel_launch(void* const* d_in, const int* in_sizes, int n_in, void* d_out, int out_size, void* d_ws,
                              size_t ws_size, hipStream_t stream) {
  if (ws_size < WS_NEED) {
    fprintf(stderr, "workspace too small: %zu < %zu\n", ws_size, (size_t)WS_NEED);
    return;
  }
  Params p{};
  const float** pp = (const float**)&p;
  for (int i = 0; i < 26; ++i) pp[i] = (const float*)d_in[i];
  p.out = (float*)d_out;
  p.ws = (char*)d_ws;
  static int grid_blocks = 0;
  if (!grid_blocks) {
    hipFuncSetAttribute((const void*)mega_kernel, hipFuncAttributeMaxDynamicSharedMemorySize, SMEM_BYTES + 16);
    int dev = 0, cus = 0, per_cu = 0;
    hipGetDevice(&dev);
    hipDeviceGetAttribute(&cus, hipDeviceAttributeMultiprocessorCount, dev);
    hipOccupancyMaxActiveBlocksPerMultiprocessor(&per_cu, mega_kernel, 512, SMEM_BYTES + 16);
    if (per_cu < 1) per_cu = 1;
    grid_blocks = cus * per_cu;
  }
#ifdef MULTI_LAUNCH
  for (int ph = 0; ph < N_PHASES; ++ph)
    hipLaunchKernelGGL(mega_kernel, dim3(grid_blocks), dim3(512), SMEM_BYTES + 16, stream, p, ph, ph + 1);
#else
  hipMemsetAsync((char*)d_ws + OFF_BAR, 0, SZ_BAR, stream);
  int b = 0, e = N_PHASES;
  void* args[] = {&p, &b, &e};
  hipError_t err = hipLaunchCooperativeKernel((const void*)mega_kernel, dim3(grid_blocks), dim3(512), args, SMEM_BYTES + 16, stream);
  if (err != hipSuccess) fprintf(stderr, "cooperative launch failed: %s (grid %d)\n", hipGetErrorString(err), grid_blocks);
#endif
}
```

```cpp
#include <hip/hip_runtime.h>
#include <hip/hip_cooperative_groups.h>
#include <cstdio>
namespace cg = cooperative_groups;

typedef unsigned short u16;
typedef short bf16x8 __attribute__((ext_vector_type(8)));
typedef short s16x4 __attribute__((ext_vector_type(4)));
typedef float f32x16 __attribute__((ext_vector_type(16)));
typedef float f32x2 __attribute__((ext_vector_type(2)));
typedef __bf16 bf16x2_t __attribute__((ext_vector_type(2)));

#define DEV __device__ __forceinline__
#define MFMA(a, b, c) __builtin_amdgcn_mfma_f32_32x32x16_bf16((a), (b), (c), 0, 0, 0)

#ifndef REP_INPROJ
#define REP_INPROJ 1
#endif
#ifndef REP_DIFF
#define REP_DIFF 1
#endif
#ifndef REP_MLA
#define REP_MLA 1
#endif
#ifndef REP_NA
#define REP_NA 1
#endif
constexpr int NB = 4, SEQ = 8192, CTXL = 256, DM = 1024;
constexpr int TP = SEQ + CTXL;
constexpr int MH = 2 * TP;
constexpr int MALL = 4 * TP;
constexpr int NIN = 8448;
constexpr int DIN = 8352;
constexpr float EPS = 1e-6f;
constexpr float LOG2E = 1.4426950408889634f;

constexpr size_t SZ_WIN = (size_t)2 * NIN * 1024 * 2;
constexpr size_t SZ_WUQ = (size_t)2 * 1024 * 384 * 2;
constexpr size_t SZ_WUKV = (size_t)2 * 1024 * 256 * 2;
constexpr size_t SZ_WBR = (size_t)2 * 3 * 1024 * 512 * 2;
constexpr size_t SZ_WOUT = (size_t)2 * 1024 * 1024 * 2;
constexpr size_t SZ_MOD = (size_t)2 * 5 * 3072 * 4;
constexpr size_t SZ_LAM = 256;
constexpr size_t SZ_CTX1 = (size_t)NB * CTXL * DM * 4;
constexpr size_t SZ_H = (size_t)MALL * 1024 * 2;
constexpr size_t SZ_HD = (size_t)MH * 512 * 2;
constexpr size_t SZ_CQ = (size_t)MH * 384 * 2;
constexpr size_t SZ_CKV = (size_t)MH * 256 * 2;
constexpr size_t SZ_KROPE = (size_t)MH * 32 * 4;
constexpr size_t SZ_SSQ = (size_t)MH * 16 * 4;
constexpr size_t SZ_Z = (size_t)MH * 1536 * 2;
constexpr size_t SZ_G = (size_t)MH * 3072 * 2;
constexpr size_t SZ_MQ = (size_t)MH * 768 * 2;

constexpr size_t OFF_WIN = 0;
constexpr size_t OFF_WUQ = OFF_WIN + SZ_WIN;
constexpr size_t OFF_WUKV = OFF_WUQ + SZ_WUQ;
constexpr size_t OFF_WBR = OFF_WUKV + SZ_WUKV;
constexpr size_t OFF_WOUT = OFF_WBR + SZ_WBR;
constexpr size_t OFF_MOD = OFF_WOUT + SZ_WOUT;
constexpr size_t OFF_LAM = OFF_MOD + SZ_MOD;
constexpr size_t OFF_CTX1 = OFF_LAM + SZ_LAM;
constexpr size_t OFF_H = OFF_CTX1 + SZ_CTX1;
constexpr size_t OFF_NAQ = OFF_H + SZ_H;
constexpr size_t OFF_NAK = OFF_NAQ + SZ_HD;
constexpr size_t OFF_NAV = OFF_NAK + SZ_HD;
constexpr size_t OFF_CQ = OFF_NAV + SZ_HD;
constexpr size_t OFF_CKV = OFF_CQ + SZ_CQ;
constexpr size_t OFF_KROPE = OFF_CKV + SZ_CKV;
constexpr size_t OFF_SSQ = OFF_KROPE + SZ_KROPE;
constexpr size_t OFF_DQ = OFF_SSQ + SZ_SSQ;
constexpr size_t OFF_DK = OFF_DQ + SZ_HD;
constexpr size_t OFF_DV = OFF_DK + SZ_HD;
constexpr size_t OFF_Z = OFF_DV + SZ_HD;
constexpr size_t OFF_G = OFF_Z + SZ_Z;
constexpr size_t OFF_MQ = OFF_G + SZ_G;
constexpr size_t OFF_MK = OFF_MQ + SZ_MQ;
constexpr size_t OFF_MV = OFF_MK + SZ_MQ;
constexpr size_t OFF_ACAT = OFF_MV + SZ_HD;
constexpr size_t OFF_BAR = OFF_ACAT + SZ_Z;
constexpr size_t SZ_BAR = 16384;
constexpr size_t WS_NEED = OFF_BAR + SZ_BAR;

constexpr int SMEM_BYTES = 3 * 49152;

struct Params {
  const float *x, *c, *ctx, *c_ctx, *norm_g, *w_ada, *b_ada, *w_in, *na_rpb, *na_q_g, *na_k_g, *mla_cq_g,
      *mla_ckv_g, *w_uq, *w_ukv, *mla_q_g, *mla_k_g, *diff_q_g, *diff_k_g, *diff_lq1, *diff_lk1, *diff_lq2,
      *diff_lk2, *diff_subln_g, *w_br, *w_out;
  float* out;
  char* ws;
};

template <typename T> DEV T* opaque_ptr(T* q) { asm volatile("" : "+s"(q)); return q; }
DEV int opaque_tid() { int t = threadIdx.x; asm volatile("" : "+v"(t)); return t; }
DEV float bf2f(u16 v) { return __uint_as_float(((unsigned)v) << 16); }
DEV unsigned pk2(float a, float b) {
  f32x2 v = {a, b};
  bf16x2_t r = __builtin_convertvector(v, bf16x2_t);
  return __builtin_bit_cast(unsigned, r);
}
DEV uint2 pk4(float a, float b, float c, float d) { return make_uint2(pk2(a, b), pk2(c, d)); }
DEV float fast_exp2(float x) { return __builtin_amdgcn_exp2f(x); }
DEV float fast_rcp(float x) { return __builtin_amdgcn_rcpf(x); }
DEV float sigmoidf_(float v) { return fast_rcp(1.f + fast_exp2(-v * LOG2E)); }
DEV float siluf_(float v) { return v * sigmoidf_(v); }
DEV float xor32(float v) { return __shfl_xor(v, 32, 64); }
DEV float half_max(float v) {
  const unsigned u = __float_as_uint(v);
  auto r = __builtin_amdgcn_permlane32_swap(u, u, false, false);
  return fmaxf(__uint_as_float(r[0]), __uint_as_float(r[1]));
}
DEV int crow_of(int reg, int h) { return (reg & 3) + 8 * (reg >> 2) + 4 * h; }
DEV void store_row32(u16* base32, const float (&v)[16], int h) {
  uint2 p[4];
#pragma unroll
  for (int g = 0; g < 4; ++g) p[g] = pk4(v[4 * g], v[4 * g + 1], v[4 * g + 2], v[4 * g + 3]);
#pragma unroll
  for (int k = 0; k < 4; k += 2) {
    auto rx = __builtin_amdgcn_permlane32_swap(p[k].x, p[k + 1].x, false, false);
    auto ry = __builtin_amdgcn_permlane32_swap(p[k].y, p[k + 1].y, false, false);
    *(uint4*)((char*)base32 + (h ? 16 : 0) + 16 * k) = make_uint4(rx[0], ry[0], rx[1], ry[1]);
  }
}

DEV void sincos_fast(float a, float& s, float& c) {
  float rev = a * 0.15915494309189535f;
  rev = rev - floorf(rev);
  s = __builtin_amdgcn_sinf(rev);
  c = __builtin_amdgcn_cosf(rev);
}

struct NoPre { DEV void operator()() const {} };

template <int NI, int MJ, int BROWS, int NSTG, typename Pre = NoPre>
DEV void gemm_main(f32x16 (&acc)[NI][MJ], const u16* __restrict__ A, int lda, const u16* __restrict__ Bt, int ldb,
                   int K, char* smem, int wrow_act, int wrow_w, int ksa = 64, int ksb = 64, Pre pre = Pre()) {
  constexpr int ABYTES = 256 * 128;
  constexpr int STAGE = ABYTES + (BROWS > 128 ? BROWS : 128) * 128;
  constexpr int NSB = BROWS / 64;
  constexpr int NLD = 4 + NSB;
  constexpr int DIST = NSTG - 1;
  const int tid = opaque_tid(), lane = tid & 63, h = lane >> 5, r = lane & 31;
  const int nk = K >> 6;
  const int cch = (tid & 7) ^ ((tid >> 4) & 7);
  const u16* ga = A + (size_t)(tid >> 3) * lda + cch * 8;
  const u16* gb = Bt + (size_t)(tid >> 3) * ldb + cch * 8;
  char* lds_t = smem + tid * 16;
  auto issue_piece = [&](int kt, int pc) {
    char* st = lds_t + (kt % NSTG) * STAGE;
    if (pc < 4)
      __builtin_amdgcn_global_load_lds((const unsigned*)(ga + (size_t)(64 * pc) * lda + (size_t)kt * ksa), (unsigned __attribute__((address_space(3)))*)(st + pc * 8192), 16, 0, 0);
    else
      __builtin_amdgcn_global_load_lds((const unsigned*)(gb + (size_t)(64 * (pc - 4)) * ldb + (size_t)kt * ksb), (unsigned __attribute__((address_space(3)))*)(st + ABYTES + (pc - 4) * 8192), 16, 0, 0);
  };
  const int x = (r >> 1) & 7;
  int xo[4];
#pragma unroll
  for (int s = 0; s < 4; ++s) xo[s] = (((2 * s + h) ^ x) << 4);
  asm volatile("s_waitcnt vmcnt(0)" ::: "memory");
#pragma unroll
  for (int d = 0; d < DIST; ++d)
#pragma unroll
    for (int pc = 0; pc < NLD; ++pc) issue_piece(d, pc);
  pre();
  for (int kt = 0; kt < nk; ++kt) {
    if (DIST == 2 && kt + 1 < nk) {
      if (NLD == 6) asm volatile("s_waitcnt vmcnt(6)" ::: "memory");
      else if (NLD == 5) asm volatile("s_waitcnt vmcnt(5)" ::: "memory");
      else asm volatile("s_waitcnt vmcnt(8)" ::: "memory");
    } else {
      asm volatile("s_waitcnt vmcnt(0)" ::: "memory");
    }
    __builtin_amdgcn_s_barrier();
    const bool pre = (kt + DIST < nk);
    const char* base = smem + (kt % NSTG) * STAGE;
    const char* pa = base + (wrow_act + r) * 128;
    const char* pw = base + ABYTES + (wrow_w + r) * 128;
    constexpr int NM = NI * MJ;
    constexpr int PPS = (NLD + 1) / 2;
#pragma unroll
    for (int s = 0; s < 4; ++s) {
      bf16x8 af[MJ], wf[NI];
#pragma unroll
      for (int j = 0; j < MJ; ++j) af[j] = *(const bf16x8*)(pa + j * 32 * 128 + xo[s]);
#pragma unroll
      for (int i = 0; i < NI; ++i) wf[i] = *(const bf16x8*)(pw + i * 32 * 128 + xo[s]);
#pragma unroll
      for (int m = 0; m < NM; ++m) {
        const int i = m / MJ, j = m % MJ;
        acc[i][j] = MFMA(wf[i], af[j], acc[i][j]);
        if (s < 2 && NM >= PPS) {
          constexpr int EVERY = (NM / PPS) > 0 ? (NM / PPS) : 1;
          if ((m + 1) % EVERY == 0) {
            const int pc = s * PPS + (m + 1) / EVERY - 1;
            if ((m + 1) / EVERY <= PPS && pc < NLD) {
              __builtin_amdgcn_sched_barrier(0);
              if (pre) issue_piece(kt + DIST, pc);
              __builtin_amdgcn_sched_barrier(0);
            }
          }
        }
        if (s < 2 && NM < PPS) {
          const int slot = s * NM + m;
          __builtin_amdgcn_sched_barrier(0);
#pragma unroll
          for (int pc = 0; pc < NLD; ++pc)
            if ((pc * 2 * NM) / NLD == slot && pre) issue_piece(kt + DIST, pc);
          __builtin_amdgcn_sched_barrier(0);
        }
      }
    }
  }
  __builtin_amdgcn_s_barrier();
}

DEV bool tile_decode(int t, int MT, int NT, int GM, int& mt, int& nt) {
  const int total = MT * NT;
  const int L = (total + 7) >> 3;
  const int x = t & 7, s = t >> 3;
  if (s >= L) return false;
  const int p = x * L + s;
  if (p >= total) return false;
  const int gsz = GM * NT;
  const int mg = p / gsz, rem = p - mg * gsz;
  const int gm = min(GM, MT - mg * GM);
  nt = rem / gm;
  mt = mg * GM + (rem - nt * gm);
  return true;
}

DEV void transpose_item(const float* __restrict__ src, int ld_src, int k0, int n0, int Kdim, u16* __restrict__ dst,
                        int mapmode  , const float* __restrict__ rowscale, char* smem) {
  float* tile = (float*)smem;
  const int tid = opaque_tid();
  {
    const int k = tid >> 3, c8 = (tid & 7) * 8;
    float4 v0 = make_float4(0, 0, 0, 0), v1 = v0;
    const int nd = n0 + c8;
    int sc = nd;
    if (mapmode == 1) sc = (nd < 2208) ? nd : (nd < 2304 ? -1 : nd - 96);
    else if (mapmode == 2) sc = ((nd & 127) < 96) ? (nd >> 7) * 96 + (nd & 127) : -1;
    if (sc >= 0) {
      const float* sp = src + (size_t)(k0 + k) * ld_src + sc;
      v0 = *(const float4*)sp;
      v1 = *(const float4*)(sp + 4);
      if (rowscale) {
        const float g = rowscale[k0 + k];
        v0.x *= g; v0.y *= g; v0.z *= g; v0.w *= g; v1.x *= g; v1.y *= g; v1.z *= g; v1.w *= g;
      }
    }
    float* tp = tile + k * 65 + c8;
    tp[0] = v0.x; tp[1] = v0.y; tp[2] = v0.z; tp[3] = v0.w; tp[4] = v1.x; tp[5] = v1.y; tp[6] = v1.z; tp[7] = v1.w;
  }
  __syncthreads();
  {
    const int n = tid >> 3, kc = (tid & 7) * 8;
    float v[8];
#pragma unroll
    for (int e = 0; e < 8; ++e) v[e] = tile[(kc + e) * 65 + n];
    uint4 o = make_uint4(pk2(v[0], v[1]), pk2(v[2], v[3]), pk2(v[4], v[5]), pk2(v[6], v[7]));
    if (mapmode == 1) {
      const int nn = n0 + n;
      *(uint4*)(dst + (size_t)(nn >> 8) * (256 * 1024) + (size_t)(k0 >> 6) * (256 * 64) + (nn & 255) * 64 + kc) = o;
    } else {
      *(uint4*)(dst + (size_t)(n0 + n) * Kdim + k0 + kc) = o;
    }
  }
  __syncthreads();
}

DEV void phase_prologue(const Params& p, char* smem) {
  char* ws = opaque_ptr(p.ws);
  constexpr int N_WIN = 2 * 16 * 132, N_WUQ = 2 * 6 * 16, N_WUKV = 2 * 4 * 16, N_WBR = 6 * 8 * 16, N_WOUT = 2 * 16 * 16,
                N_MOD = 96;
  constexpr int E0 = N_WIN, E1 = E0 + N_WUQ, E2 = E1 + N_WUKV, E3 = E2 + N_WBR, E4 = E3 + N_WOUT, E5 = E4 + N_MOD,
                E6 = E5 + 1;
  for (int it = blockIdx.x; it < E6; it += gridDim.x) {
    if (it < E0) {
      const int l = it / (16 * 132), r = it % (16 * 132), kt = r / 132, nt = r % 132;
      transpose_item(p.w_in + (size_t)l * 1024 * DIN, DIN, kt * 64, nt * 64, 1024, (u16*)(ws + OFF_WIN) + (size_t)l * NIN * 1024,
                     1, nullptr, smem);
    } else if (it < E1) {
      const int q = it - E0, l = q / 96, r = q % 96, kt = r / 16, nt = r % 16;
      transpose_item(p.w_uq + (size_t)l * 384 * 768, 768, kt * 64, nt * 64, 384, (u16*)(ws + OFF_WUQ) + (size_t)l * 1024 * 384, 2,
                     p.mla_cq_g + l * 384, smem);
    } else if (it < E2) {
      const int q = it - E1, l = q / 64, r = q % 64, kt = r / 16, nt = r % 16;
      transpose_item(p.w_ukv + (size_t)l * 256 * 1024, 1024, kt * 64, nt * 64, 256,
                     (u16*)(ws + OFF_WUKV) + (size_t)l * 1024 * 256, 0, p.mla_ckv_g + l * 256, smem);
    } else if (it < E3) {
      const int q = it - E2, mat = q / 128, r = q % 128, kt = r / 16, nt = r % 16;
      transpose_item(p.w_br + (size_t)mat * 512 * 1024, 1024, kt * 64, nt * 64, 512,
                     (u16*)(ws + OFF_WBR) + (size_t)mat * 1024 * 512, 0, nullptr, smem);
    } else if (it < E4) {
      const int q = it - E3, l = q / 256, r = q % 256, kt = r / 16, nt = r % 16;
      transpose_item(p.w_out + (size_t)l * 1024 * 1024, 1024, kt * 64, nt * 64, 1024,
                     (u16*)(ws + OFF_WOUT) + (size_t)l * 1024 * 1024, 0, nullptr, smem);
    } else if (it < E5) {
      const int q = it - E4, l = q / 48, n0 = (q % 48) * 64;
      float* sv = (float*)smem;
      float* red = sv + 5 * 1024;
      const int tid = opaque_tid();
      for (int i = tid; i < 5 * 1024; i += 512) {
        const int rr = i >> 10, k = i & 1023;
        const float v = (rr < 4) ? p.c[rr * 1024 + k] : p.c_ctx[k];
        sv[i] = v / (1.f + __expf(-v));
      }
      __syncthreads();
      const int cc = tid & 63, kg = tid >> 6;
      float a[5] = {0, 0, 0, 0, 0};
      const float* wp = p.w_ada + (size_t)l * 1024 * 3072 + n0 + cc;
#pragma unroll 4
      for (int k = kg * 128; k < kg * 128 + 128; ++k) {
        const float w = wp[(size_t)k * 3072];
#pragma unroll
        for (int rr = 0; rr < 5; ++rr) a[rr] += sv[rr * 1024 + k] * w;
      }
#pragma unroll
      for (int rr = 0; rr < 5; ++rr) red[(kg * 5 + rr) * 64 + cc] = a[rr];
      __syncthreads();
      if (tid < 320) {
        const int rr = tid >> 6, c2 = tid & 63;
        float s = 0;
#pragma unroll
        for (int g = 0; g < 8; ++g) s += red[(g * 5 + rr) * 64 + c2];
        s += p.b_ada[l * 3072 + n0 + c2];
        ((float*)(ws + OFF_MOD))[(l * 5 + rr) * 3072 + n0 + c2] = s;
      }
      __syncthreads();
    } else {
      const int tl = opaque_tid();
      if (tl < 2) {
        const int l = tl;
        float s1 = 0, s2 = 0;
        for (int i = 0; i < 64; ++i) {
          s1 += p.diff_lq1[l * 64 + i] * p.diff_lk1[l * 64 + i];
          s2 += p.diff_lq2[l * 64 + i] * p.diff_lk2[l * 64 + i];
        }
        const float lam_init = 0.8f - 0.6f * expf(-0.3f * (float)l);
        ((float*)(ws + OFF_LAM))[l] = expf(s1) - expf(s2) + lam_init;
        ((float*)(ws + OFF_LAM))[2 + l] = lam_init;
      }
    }
  }
}

DEV void phase_norm(const Params& p, int l) {
  char* ws = opaque_ptr(p.ws);
  const float* xs = l == 0 ? p.x : p.out;
  const float* cs = l == 0 ? p.ctx : (const float*)(ws + OFF_CTX1);
  const float* mod = (const float*)(ws + OFF_MOD) + (size_t)l * 5 * 3072;
  const float* g = p.norm_g + l * 1024;
  u16* H = (u16*)(ws + OFF_H);
  const int tid = opaque_tid(), lane = tid & 63;
  for (int m = blockIdx.x * 8 + (tid >> 6); m < MALL; m += gridDim.x * 8) {
    const int b = m / TP, tp = m - b * TP;
    const float* src = (tp < CTXL) ? cs + ((size_t)b * CTXL + tp) * DM : xs + ((size_t)b * SEQ + (tp - CTXL)) * DM;
    const float* md = mod + ((tp < CTXL) ? 4 : b) * 3072;
    float4 v[4];
    float ss = 0;
#pragma unroll
    for (int i = 0; i < 4; ++i) {
      v[i] = *(const float4*)(src + i * 256 + lane * 4);
      ss += v[i].x * v[i].x + v[i].y * v[i].y + v[i].z * v[i].z + v[i].w * v[i].w;
    }
#pragma unroll
    for (int o = 1; o < 64; o <<= 1) ss += __shfl_xor(ss, o, 64);
    const float rs = rsqrtf(ss * (1.f / 1024.f) + EPS);
#pragma unroll
    for (int i = 0; i < 4; ++i) {
      const int n = i * 256 + lane * 4;
      const float4 gg = *(const float4*)(g + n);
      const float4 sh = *(const float4*)(md + n);
      const float4 sc = *(const float4*)(md + 1024 + n);
      const float o0 = v[i].x * rs * gg.x * (1.f + sc.x) + sh.x;
      const float o1 = v[i].y * rs * gg.y * (1.f + sc.y) + sh.y;
      const float o2 = v[i].z * rs * gg.z * (1.f + sc.z) + sh.z;
      const float o3 = v[i].w * rs * gg.w * (1.f + sc.w) + sh.w;
      *(uint2*)(H + (size_t)(m >> 8) * (256 * 1024) + (size_t)(n >> 6) * (256 * 64) + (m & 255) * 64 + (n & 63)) = pk4(o0, o1, o2, o3);
    }
  }
}

DEV void inproj_epilogue(f32x16 (&acc)[2][2], int fb, int m0w, const Params& p, int l) {
  char* ws = opaque_ptr(p.ws);
  const int lane = opaque_tid() & 63, h = lane >> 5, r = lane & 31;
  if (fb == 35) return;
  const bool is_qk = (fb < 16) || (fb >= 36 && fb < 52);
  if (is_qk) {
    const float* gain;
    u16* dst;
    float qs = 1.f;
    bool rope = false;
    int head;
    if (fb < 8) { gain = p.na_q_g + l * 64; dst = (u16*)(ws + OFF_NAQ); head = fb; qs = 0.125f * LOG2E; }
    else if (fb < 16) { gain = p.na_k_g + l * 64; dst = (u16*)(ws + OFF_NAK); head = fb - 8; }
    else if (fb < 44) { gain = p.diff_q_g + l * 64; dst = (u16*)(ws + OFF_DQ); head = fb - 36; qs = 0.125f * LOG2E; rope = true; }
    else { gain = p.diff_k_g + l * 64; dst = (u16*)(ws + OFF_DK); head = fb - 44; rope = true; }
#pragma unroll
    for (int j = 0; j < 2; ++j) {
      const int m = m0w + 32 * j + r;
      const int bl = m / TP, tp = m - bl * TP;
      float ss = 0;
#pragma unroll
      for (int i = 0; i < 2; ++i)
#pragma unroll
        for (int e = 0; e < 16; ++e) ss += acc[i][j][e] * acc[i][j][e];
      ss += xor32(ss);
      const float rs = rsqrtf(ss * (1.f / 64.f) + EPS);
      u16* drow = dst + ((size_t)(bl * 8 + head) * TP + tp) * 64;
      const bool do_rope = rope && (tp >= CTXL);
      const int pos = tp - CTXL;
      const float prow = (float)(pos >> 6), pcol = (float)(pos & 63);
      float oa[16], ob[16];
#pragma unroll
      for (int g4 = 0; g4 < 4; ++g4) {
        const int f1 = 8 * g4 + 4 * h;
        const float4 ga = *(const float4*)(gain + f1);
        const float4 gb = *(const float4*)(gain + 32 + f1);
        float a[4], b[4];
        a[0] = acc[0][j][4 * g4 + 0] * rs * ga.x; a[1] = acc[0][j][4 * g4 + 1] * rs * ga.y;
        a[2] = acc[0][j][4 * g4 + 2] * rs * ga.z; a[3] = acc[0][j][4 * g4 + 3] * rs * ga.w;
        b[0] = acc[1][j][4 * g4 + 0] * rs * gb.x; b[1] = acc[1][j][4 * g4 + 1] * rs * gb.y;
        b[2] = acc[1][j][4 * g4 + 2] * rs * gb.z; b[3] = acc[1][j][4 * g4 + 3] * rs * gb.w;
        if (do_rope) {
#pragma unroll
          for (int e = 0; e < 4; ++e) {
            const int f = f1 + e;
            const float inv = fast_exp2(-(float)(f & 15) * 0.8304820237218406f);
            const float ang = ((f < 16) ? prow : pcol) * inv;
            float sn, cs;
            sincos_fast(ang, sn, cs);
            const float x1 = a[e], x2 = b[e];
            a[e] = x1 * cs - x2 * sn;
            b[e] = x2 * cs + x1 * sn;
          }
        }
#pragma unroll
        for (int e = 0; e < 4; ++e) { oa[4 * g4 + e] = a[e] * qs; ob[4 * g4 + e] = b[e] * qs; }
      }
      store_row32(drow, oa, h);
      store_row32(drow + 32, ob, h);
    }
    return;
  }
  if (fb == 34) {
    float* dst = (float*)(ws + OFF_KROPE);
#pragma unroll
    for (int j = 0; j < 2; ++j) {
      const int m = m0w + 32 * j + r;
#pragma unroll
      for (int g4 = 0; g4 < 4; ++g4)
        *(float4*)(dst + (size_t)m * 32 + 8 * g4 + 4 * h) =
            make_float4(acc[0][j][4 * g4], acc[0][j][4 * g4 + 1], acc[0][j][4 * g4 + 2], acc[0][j][4 * g4 + 3]);
    }
    return;
  }
  int mode = 0;
  int ssq_slot = -1;
  u16* dst;
  size_t pitch;
  int col0;
  bool headmajor = false;
  int hm_heads = 0, hm_head = 0, hm_w = 0;
  if (fb < 24) { headmajor = true; dst = (u16*)(ws + OFF_NAV); hm_heads = 8; hm_head = fb - 16; hm_w = 64; col0 = 0; pitch = 0; }
  else if (fb < 30) { dst = (u16*)(ws + OFF_CQ); pitch = 384; col0 = (fb - 24) * 64; ssq_slot = fb - 24; }
  else if (fb < 34) { dst = (u16*)(ws + OFF_CKV); pitch = 256; col0 = (fb - 30) * 64; ssq_slot = 6 + fb - 30; }
  else if (fb < 60) { headmajor = true; dst = (u16*)(ws + OFF_DV); hm_heads = 4; hm_head = (fb - 52) >> 1; hm_w = 128; col0 = ((fb - 52) & 1) * 64; pitch = 0; }
  else if (fb < 84) { dst = (u16*)(ws + OFF_Z); pitch = 1536; col0 = (fb - 60) * 64; mode = 1; }
  else { dst = (u16*)(ws + OFF_G); pitch = 3072; col0 = (fb - 84) * 64; mode = 2; }
#pragma unroll
  for (int j = 0; j < 2; ++j) {
    const int m = m0w + 32 * j + r;
    u16* drow;
    if (headmajor) {
      const int bl = m / TP, tp = m - bl * TP;
      drow = dst + ((size_t)(bl * hm_heads + hm_head) * TP + tp) * hm_w + col0;
    } else {
      drow = dst + (size_t)m * pitch + col0;
    }
    float ss = 0;
#pragma unroll
    for (int i = 0; i < 2; ++i) {
      float v[16];
#pragma unroll
      for (int e = 0; e < 16; ++e) {
        float t = acc[i][j][e];
        ss += t * t;
        if (mode == 1) t = siluf_(t);
        else if (mode == 2) t = sigmoidf_(t);
        v[e] = t;
      }
      store_row32(drow + 32 * i, v, h);
    }
    if (ssq_slot >= 0) {
      ss += xor32(ss);
      if (h == 0) ((float*)(ws + OFF_SSQ))[(size_t)m * 16 + ssq_slot] = ss;
    }
  }
}

DEV void phase_inproj(const Params& p, int l, int hf, char* smem) {
  char* ws = opaque_ptr(p.ws);
  const u16* H = (const u16*)(ws + OFF_H) + (size_t)hf * MH * 1024;
  const u16* W = (const u16*)(ws + OFF_WIN) + (size_t)l * NIN * 1024;
  const int w = opaque_tid() >> 6, wm = w >> 1, wn = w & 1;
  const int nslots = ((66 * 33 + 7) / 8) * 8;
  for (int t = blockIdx.x; t < nslots; t += gridDim.x) {
    int mt, nt;
    if (!tile_decode(t, 66, 33, 3, mt, nt)) continue;
    if (l == 1 && (mt % 33) == 0 && !((nt >= 2 && nt <= 5) || nt == 7 || nt == 8 || (nt >= 11 && nt <= 14))) continue;
    f32x16 acc[4][2];
#pragma unroll
    for (int i = 0; i < 4; ++i)
#pragma unroll
      for (int j = 0; j < 2; ++j)
#pragma unroll
        for (int e = 0; e < 16; ++e) acc[i][j][e] = 0.f;
    gemm_main<4, 2, 256, 2>(acc, H + (size_t)mt * 256 * 1024, 64, W + (size_t)nt * 256 * 1024, 64, 1024, smem, wm * 64, wn * 128, 256 * 64, 256 * 64);
    inproj_epilogue(*(f32x16(*)[2][2])&acc[0], nt * 4 + wn * 2, mt * 256 + wm * 64, p, l);
    inproj_epilogue(*(f32x16(*)[2][2])&acc[2], nt * 4 + wn * 2 + 1, mt * 256 + wm * 64, p, l);
  }
}

DEV void phase_upproj(const Params& p, int l, int hf, char* smem) {
  char* ws = opaque_ptr(p.ws);
  const int tid = opaque_tid(), w = tid >> 6, lane = tid & 63, h = lane >> 5, r = lane & 31;
  const int nslots = ((66 * 16 + 7) / 8) * 8;
  const float* ssq = (const float*)(ws + OFF_SSQ);
  for (int t = blockIdx.x; t < nslots; t += gridDim.x) {
    int mt, nt;
    if (!tile_decode(t, 66, 16, 3, mt, nt)) continue;
    if (l == 1 && (mt % 33) == 0 && nt < 8) continue;
    f32x16 acc[4][1];
#pragma unroll
    for (int i = 0; i < 4; ++i)
#pragma unroll
      for (int e = 0; e < 16; ++e) acc[i][0][e] = 0.f;
    const int m = mt * 256 + w * 32 + r;
    const int bl = m / TP, tp = m - bl * TP;
    const bool latent = tp >= CTXL;
    const int pos = tp - CTXL;
    const float prow = (float)(pos >> 6), pcol = (float)(pos & 63);
    if (nt < 8) {
      const int hd = nt;
      float sqv[6];
      auto load_sq = [&]() {
        const float* sq = ssq + (size_t)m * 16;
#pragma unroll
        for (int i = 0; i < 6; ++i) sqv[i] = sq[i];
      };
      gemm_main<4, 1, 128, 3>(acc, (const u16*)(ws + OFF_CQ) + (size_t)mt * 256 * 384, 384,
                      (const u16*)(ws + OFF_WUQ) + ((size_t)l * 1024 + hd * 128) * 384, 384, 384, smem, w * 32, 0, 64, 64, load_sq);
      const float rcq = rsqrtf((sqv[0] + sqv[1] + sqv[2] + sqv[3] + sqv[4] + sqv[5]) * (1.f / 384.f) + EPS);
      float ss = 0;
#pragma unroll
      for (int i = 0; i < 3; ++i)
#pragma unroll
        for (int e = 0; e < 16; ++e) { acc[i][0][e] *= rcq; ss += acc[i][0][e] * acc[i][0][e]; }
      ss += xor32(ss);
      const float rs = rsqrtf(ss * (1.f / 96.f) + EPS);
      const float* gain = p.mla_q_g + l * 96;
      const float qs = 0.10206207261596577f * LOG2E;
      u16* drow = (u16*)(ws + OFF_MQ) + ((size_t)(bl * 8 + hd) * TP + tp) * 96;
#pragma unroll
      for (int i = 0; i < 3; ++i)
#pragma unroll
        for (int e = 0; e < 16; ++e) acc[i][0][e] *= rs * gain[32 * i + crow_of(e, h)];
      if (latent) {
#pragma unroll
        for (int e = 0; e < 8; ++e) {
          const int a = crow_of(e, h);
          const float inv = fast_exp2(-(float)(a & 7) * 1.6609640474436813f);
          const float ang = ((a < 8) ? prow : pcol) * inv;
          float sn, cs;
          sincos_fast(ang, sn, cs);
          const float x1 = acc[2][0][e], x2 = acc[2][0][e + 8];
          acc[2][0][e] = x1 * cs - x2 * sn;
          acc[2][0][e + 8] = x2 * cs + x1 * sn;
        }
      }
#pragma unroll
      for (int i = 0; i < 3; ++i) {
        float ov[16];
#pragma unroll
        for (int e = 0; e < 16; ++e) ov[e] = acc[i][0][e] * qs;
        store_row32(drow + 32 * i, ov, h);
      }
    } else {
      const int hd = nt - 8;
      float sqv[4];
      float kr[16];
      auto load_pre = [&]() {
        const float* sq = ssq + (size_t)m * 16 + 6;
#pragma unroll
        for (int i = 0; i < 4; ++i) sqv[i] = sq[i];
        const float* krp = (const float*)(ws + OFF_KROPE) + (size_t)m * 32;
#pragma unroll
        for (int g4 = 0; g4 < 4; ++g4) {
          const float4 v = *(const float4*)(krp + 8 * g4 + 4 * h);
          kr[4 * g4] = v.x; kr[4 * g4 + 1] = v.y; kr[4 * g4 + 2] = v.z; kr[4 * g4 + 3] = v.w;
        }
      };
      gemm_main<4, 1, 128, 3>(acc, (const u16*)(ws + OFF_CKV) + (size_t)mt * 256 * 256, 256,
                      (const u16*)(ws + OFF_WUKV) + ((size_t)l * 1024 + hd * 128) * 256, 256, 256, smem, w * 32, 0, 64, 64, load_pre);
      const float rckv = rsqrtf((sqv[0] + sqv[1] + sqv[2] + sqv[3]) * (1.f / 256.f) + EPS);
      float ss = 0;
#pragma unroll
      for (int i = 0; i < 4; ++i)
#pragma unroll
        for (int e = 0; e < 16; ++e) { acc[i][0][e] *= rckv; if (i < 2) ss += acc[i][0][e] * acc[i][0][e]; }
#pragma unroll
      for (int e = 0; e < 16; ++e) ss += kr[e] * kr[e];
      ss += xor32(ss);
      const float rs = rsqrtf(ss * (1.f / 96.f) + EPS);
      const float* gain = p.mla_k_g + l * 96;
      u16* krow = (u16*)(ws + OFF_MK) + ((size_t)(bl * 8 + hd) * TP + tp) * 96;
      u16* vrow = (u16*)(ws + OFF_MV) + ((size_t)(bl * 8 + hd) * TP + tp) * 64;
#pragma unroll
      for (int e = 0; e < 16; ++e) kr[e] *= rs * gain[64 + crow_of(e, h)];
      if (latent) {
#pragma unroll
        for (int e = 0; e < 8; ++e) {
          const int a = crow_of(e, h);
          const float inv = fast_exp2(-(float)(a & 7) * 1.6609640474436813f);
          const float ang = ((a < 8) ? prow : pcol) * inv;
          float sn, cs;
          sincos_fast(ang, sn, cs);
          const float x1 = kr[e], x2 = kr[e + 8];
          kr[e] = x1 * cs - x2 * sn;
          kr[e + 8] = x2 * cs + x1 * sn;
        }
      }
#pragma unroll
      for (int i = 0; i < 2; ++i) {
        float ov[16];
#pragma unroll
        for (int g4 = 0; g4 < 4; ++g4) {
          const int f = 32 * i + 8 * g4 + 4 * h;
          const float4 gg = *(const float4*)(gain + f);
          ov[4 * g4] = acc[i][0][4 * g4] * rs * gg.x; ov[4 * g4 + 1] = acc[i][0][4 * g4 + 1] * rs * gg.y;
          ov[4 * g4 + 2] = acc[i][0][4 * g4 + 2] * rs * gg.z; ov[4 * g4 + 3] = acc[i][0][4 * g4 + 3] * rs * gg.w;
        }
        store_row32(krow + 32 * i, ov, h);
      }
      store_row32(krow + 64, kr, h);
#pragma unroll
      for (int i = 2; i < 4; ++i) {
        float ov[16];
#pragma unroll
        for (int e = 0; e < 16; ++e) ov[e] = acc[i][0][e];
        store_row32(vrow + 32 * (i - 2), ov, h);
      }
    }
  }
}

struct FlashArgs {
  const u16 *Q0, *Q1;
  const u16 *K0, *K1;
  const u16* V;
  int q_t0;
  int n_tiles;
  int lt0;
  const float* rpb;
  int r0;
};

template <int DQK, int DV, int NKH, int MODE>
DEV void flash_unit(const FlashArgs& fa, char* smem, f32x16 (&oacc)[DV / 32], float& linv_out) {
  constexpr int NSTG = 4;
  constexpr int K64B = NKH * 8;
  constexpr int K32B = (DQK == 96) ? 4 : 0;
  constexpr int VB = DV / 8;
  constexpr int NBLK = K64B + K32B + VB;
  constexpr int STAGE = NBLK * 1024;
  constexpr int OFF_K32 = K64B * 1024;
  constexpr int OFF_V = (K64B + K32B) * 1024;
  constexpr int LPT = (NBLK + 7) / 8;
  constexpr int NS = DQK / 16;
  constexpr int NV = DV / 32;
  static_assert(LPT <= 4, "LPT");
  const int tid = opaque_tid(), w = tid >> 6, lane = tid & 63, h = lane >> 5, r = lane & 31;
  const int kh = (NKH == 2) ? (w >> 2) : 0;
  const int qsub = (NKH == 2) ? (w & 3) : w;
  float* rpbs = (float*)(smem + NSTG * STAGE);

  auto dma_src = [&](int i, long& stride) -> const char* {
    const int b = 8 * i + w;
    if (b < K64B) {
      const int k2 = b >> 3, q = (b & 7) * 64 + lane, row = q >> 3, c = (q & 7) ^ ((row >> 1) & 7);
      stride = 64 * DQK * 2;
      return (const char*)(k2 ? fa.K1 : fa.K0) + row * (DQK * 2) + c * 16;
    } else if (b < K64B + K32B) {
      const int q = (b - K64B) * 64 + lane, row = q >> 2, c = (q & 3) ^ ((row >> 2) & 3);
      stride = 64 * DQK * 2;
      return (const char*)fa.K0 + row * (DQK * 2) + 128 + c * 16;
    } else {
      const int q = (b - K64B - K32B) * 64 + lane;
      stride = 64 * DV * 2;
      if (DV == 64) {
        const int row = q >> 3, c = (q & 7) ^ ((row & 2) << 1);
        return (const char*)fa.V + row * 128 + c * 16;
      } else {
        const int row = q >> 4, c = (q & 15) ^ (((row & 3) << 2) | ((row >> 2) & 3));
        return (const char*)fa.V + row * 256 + c * 16;
      }
    }
  };
  long str0 = 0, str1 = 0, str2 = 0, str3 = 0;
  const char* src0 = dma_src(0, str0);
  const char* src1 = (LPT > 1) ? dma_src(1, str1) : nullptr;
  const char* src2 = (LPT > 2) ? dma_src(2, str2) : nullptr;
  const char* src3 = (LPT > 3) ? dma_src(3, str3) : nullptr;
  const int nld = (NBLK % 8 == 0) ? LPT : ((w < (NBLK % 8)) ? LPT : LPT - 1);
  auto tile_id = [&](int it) { return it < 4 ? it : it - 4 + fa.lt0; };
  char* lds_t = smem + w * 1024 + lane * 16;
  auto issue_piece = [&](int it, int pc) {
    const long t = tile_id(it);
    char* st = lds_t + (it & (NSTG - 1)) * STAGE;
    if (pc == 0)
      __builtin_amdgcn_global_load_lds((const unsigned*)(src0 + t * str0), (unsigned __attribute__((address_space(3)))*)(st), 16, 0, 0);
    if (pc == 1 && LPT > 1 && (LPT - 1 > 1 || nld > 1))
      __builtin_amdgcn_global_load_lds((const unsigned*)(src1 + t * str1), (unsigned __attribute__((address_space(3)))*)(st + 8192), 16, 0, 0);
    if (pc == 2 && LPT > 2 && (LPT - 1 > 2 || nld > 2))
      __builtin_amdgcn_global_load_lds((const unsigned*)(src2 + t * str2), (unsigned __attribute__((address_space(3)))*)(st + 16384), 16, 0, 0);
    if (pc == 3 && LPT > 3 && nld > 3)
      __builtin_amdgcn_global_load_lds((const unsigned*)(src3 + t * str3), (unsigned __attribute__((address_space(3)))*)(st + 24576), 16, 0, 0);
  };
  auto issue = [&](int it) {
#pragma unroll
    for (int pc = 0; pc < LPT; ++pc) issue_piece(it, pc);
  };

  bf16x8 qf[NS];
  {
    const u16* qp = (kh ? fa.Q1 : fa.Q0) + (size_t)(fa.q_t0 + qsub * 32 + r) * DQK + 8 * h;
#pragma unroll
    for (int s = 0; s < NS; ++s) qf[s] = *(const bf16x8*)(qp + 16 * s);
  }
  int na_row = 0, na_rs = 0, na_qc = 0, na_cstart = 0;
  if (MODE == 1) {
    na_row = fa.r0 + (w >> 1);
    na_rs = min(max(na_row - 4, 0), 120);
    na_qc = (w & 1) * 32 + r;
    na_cstart = min(max(na_qc - 8, 0), 48);
    for (int i = tid; i < 15 * 31; i += 512) rpbs[i] = fa.rpb[i] * LOG2E;
  }
#pragma unroll
  for (int v = 0; v < NV; ++v)
#pragma unroll
    for (int e = 0; e < 16; ++e) oacc[v][e] = 0.f;
  float mrun = 0.f;
  f32x16 negm;
#pragma unroll
  for (int e = 0; e < 16; ++e) negm[e] = 0.f;
  float lrun = 0.f;

  const int kx = (r >> 1) & 7;
  int kxo[4];
#pragma unroll
  for (int s = 0; s < 4; ++s) kxo[s] = (((2 * s + h) ^ kx) << 4);
  const int k32x = (r >> 2) & 3;
  const int blk = (lane >> 4) & 1, i16 = lane & 15, q4 = i16 >> 2, p4 = i16 & 3;
  int vlow0, vlow1, vhi[NV];
  if (DV == 64) {
    vlow0 = (4 * h + q4) * 128 + (blk * 2 + (p4 >> 1)) * 16 + (p4 & 1) * 8;
    vlow1 = vlow0;
#pragma unroll
    for (int v = 0; v < NV; ++v) vhi[v] = ((v ^ ((q4 >> 1) & 1)) * 64);
  } else {
    vlow0 = (4 * h + q4) * 256 + (((blk * 2 + (p4 >> 1)) ^ (h)) * 16) + (p4 & 1) * 8;
    vlow1 = (4 * h + q4) * 256 + (((blk * 2 + (p4 >> 1)) ^ (2 + h)) * 16) + (p4 & 1) * 8;
#pragma unroll
    for (int v = 0; v < NV; ++v) vhi[v] = ((v ^ q4) * 64);
  }
  constexpr int VROW = DV * 2;

  asm volatile("s_waitcnt vmcnt(0)" ::: "memory");
  issue(0);
  issue(1);
  issue(2);

  for (int it = 0; it < fa.n_tiles; ++it) {
    {
      const int newer = min(2, fa.n_tiles - 1 - it) * nld;
      if (newer >= 8) asm volatile("s_waitcnt vmcnt(8)" ::: "memory");
      else if (newer == 6) asm volatile("s_waitcnt vmcnt(6)" ::: "memory");
      else if (newer == 4) asm volatile("s_waitcnt vmcnt(4)" ::: "memory");
      else if (newer == 3) asm volatile("s_waitcnt vmcnt(3)" ::: "memory");
      else if (newer == 2) asm volatile("s_waitcnt vmcnt(2)" ::: "memory");
      else asm volatile("s_waitcnt vmcnt(0)" ::: "memory");
    }
    __builtin_amdgcn_s_barrier();
    const bool pre = (it + 3 < fa.n_tiles);
    bool active = true;
    int krow = 0;
    if (MODE == 1 && it >= 4) {
      krow = tile_id(it) - 4;
      active = (krow >= na_rs) && (krow < na_rs + 8);
    }
    if (active) {
      const char* sb = smem + (it & (NSTG - 1)) * STAGE;
      const char* kb = sb + kh * 8192 + r * 128;
      const char* kb32 = sb + OFF_K32 + r * 64;
      const char* vb = sb + OFF_V;
      f32x16 st[2];
      bf16x8 kfr[2][NS];
#pragma unroll
      for (int k2 = 0; k2 < 2; ++k2)
#pragma unroll
        for (int s = 0; s < NS; ++s) {
          if (s < 4) kfr[k2][s] = *(const bf16x8*)(kb + k2 * 32 * 128 + kxo[s]);
          else kfr[k2][s] = *(const bf16x8*)(kb32 + k2 * 32 * 64 + (((2 * (s - 4) + h) ^ k32x) << 4));
        }
      __builtin_amdgcn_sched_barrier(0);
#pragma unroll
      for (int k2 = 0; k2 < 2; ++k2) {
#pragma unroll
        for (int s = 0; s < NS; ++s) {
          const bf16x8 kf = kfr[k2][s];
          if (s == 0) st[k2] = MFMA(kf, qf[s], negm);
          else st[k2] = MFMA(kf, qf[s], st[k2]);
          constexpr int NQK = 2 * NS, EVERY = NQK / LPT;
          const int m = k2 * NS + s;
          if ((m + 1) % EVERY == 0 && (m + 1) / EVERY <= LPT) {
            __builtin_amdgcn_sched_barrier(0);
            if (pre) issue_piece(it + 3, (m + 1) / EVERY - 1);
            __builtin_amdgcn_sched_barrier(0);
          }
        }
      }
      if (MODE == 1 && it >= 4) {
        const int dr = krow - na_row + 7;
        const float* bp = rpbs + dr * 31;
#pragma unroll
        for (int k2 = 0; k2 < 2; ++k2)
#pragma unroll
          for (int e = 0; e < 16; ++e) {
            const int kc = k2 * 32 + crow_of(e, h);
            const bool valid = (kc >= na_cstart) && (kc < na_cstart + 16);
            const int idx = min(max(kc - na_qc + 15, 0), 30);
            const float bv = bp[idx];
            st[k2][e] = valid ? st[k2][e] + bv : -1e30f;
          }
      }
      float rel = st[0][0];
#pragma unroll
      for (int e = 1; e < 16; ++e) rel = fmaxf(rel, st[0][e]);
#pragma unroll
      for (int e = 0; e < 16; ++e) rel = fmaxf(rel, st[1][e]);
      rel = half_max(rel);
      const bool first = (it == 0);
      if (first || __builtin_amdgcn_ballot_w64(rel > 8.f) != 0) {
        const float d = first ? rel : fmaxf(rel, 0.f);
        const float alpha = fast_exp2(-d);
        mrun += d;
#pragma unroll
        for (int k2 = 0; k2 < 2; ++k2)
#pragma unroll
          for (int e = 0; e < 16; ++e) st[k2][e] -= d;
#pragma unroll
        for (int v = 0; v < NV; ++v)
#pragma unroll
          for (int e = 0; e < 16; ++e) oacc[v][e] *= alpha;
#pragma unroll
        for (int e = 0; e < 16; ++e) negm[e] = -mrun;
        lrun *= alpha;
      }
      float psum = 0.f;
#pragma unroll
      for (int k2 = 0; k2 < 2; ++k2)
#pragma unroll
        for (int e = 0; e < 16; ++e) { st[k2][e] = fast_exp2(st[k2][e]); psum += st[k2][e]; }
      lrun += psum;
      bf16x8 pf[2][2];
#pragma unroll
      for (int k2 = 0; k2 < 2; ++k2)
#pragma unroll
        for (int s2 = 0; s2 < 2; ++s2) {
          uint4 u = make_uint4(pk2(st[k2][8 * s2], st[k2][8 * s2 + 1]), pk2(st[k2][8 * s2 + 2], st[k2][8 * s2 + 3]),
                               pk2(st[k2][8 * s2 + 4], st[k2][8 * s2 + 5]), pk2(st[k2][8 * s2 + 6], st[k2][8 * s2 + 7]));
          pf[k2][s2] = __builtin_bit_cast(bf16x8, u);
        }
#pragma unroll
      for (int v = 0; v < NV; ++v)
#pragma unroll
        for (int k2 = 0; k2 < 2; ++k2)
#pragma unroll
          for (int s2 = 0; s2 < 2; ++s2) {
            const char* a1 = vb + (k2 * 32 + s2 * 16) * VROW + vhi[v] + vlow0;
            const char* a2 = vb + (k2 * 32 + s2 * 16 + 8) * VROW + vhi[v] + vlow1;
            s16x4 lo = __builtin_amdgcn_ds_read_tr16_b64_v4i16((__attribute__((address_space(3))) s16x4*)(a1));
            s16x4 hi = __builtin_amdgcn_ds_read_tr16_b64_v4i16((__attribute__((address_space(3))) s16x4*)(a2));
            const bf16x8 vf = __builtin_shufflevector(lo, hi, 0, 1, 2, 3, 4, 5, 6, 7);
            oacc[v] = MFMA(vf, pf[k2][s2], oacc[v]);
          }
    } else {
      if (pre) issue(it + 3);
    }
  }
  __builtin_amdgcn_s_barrier();
  linv_out = fast_rcp(lrun + xor32(lrun));
}

template <int NV>
DEV void attn_store(f32x16 (&o)[NV], float scale_lane, const u16* zrow, u16* arow, const float* vgain  ) {
  const int lane = opaque_tid() & 63, h = lane >> 5;
#pragma unroll
  for (int v = 0; v < NV; ++v) {
    float ov[16];
#pragma unroll
    for (int g4 = 0; g4 < 4; ++g4) {
      const int f = 32 * v + 8 * g4 + 4 * h;
      const uint2 zz = *(const uint2*)(zrow + f);
      float z0 = __uint_as_float(zz.x << 16), z1 = __uint_as_float(zz.x & 0xffff0000u);
      float z2 = __uint_as_float(zz.y << 16), z3 = __uint_as_float(zz.y & 0xffff0000u);
      float a0 = o[v][4 * g4] * scale_lane, a1 = o[v][4 * g4 + 1] * scale_lane, a2 = o[v][4 * g4 + 2] * scale_lane,
            a3 = o[v][4 * g4 + 3] * scale_lane;
      if (vgain) {
        const float4 gg = *(const float4*)(vgain + f);
        a0 *= gg.x; a1 *= gg.y; a2 *= gg.z; a3 *= gg.w;
      }
      ov[4 * g4] = a0 * z0; ov[4 * g4 + 1] = a1 * z1; ov[4 * g4 + 2] = a2 * z2; ov[4 * g4 + 3] = a3 * z3;
    }
    store_row32(arow + 32 * v, ov, h);
  }
}

DEV void attn_diff_unit(const Params& p, int l, int bl, int hd, int q_t0, int n_tiles, char* smem) {
  char* ws = opaque_ptr(p.ws);
  const int tid = opaque_tid(), w = tid >> 6, lane = tid & 63, r = lane & 31;
  const float lam = ((const float*)(ws + OFF_LAM))[l];
  const float lam_init = ((const float*)(ws + OFF_LAM))[2 + l];
  FlashArgs fa;
  fa.rpb = nullptr; fa.r0 = 0; fa.lt0 = 4; fa.n_tiles = n_tiles; fa.q_t0 = q_t0;
  fa.Q0 = (const u16*)(ws + OFF_DQ) + (size_t)(bl * 8 + hd * 2) * TP * 64;
  fa.Q1 = fa.Q0 + (size_t)TP * 64;
  fa.K0 = (const u16*)(ws + OFF_DK) + (size_t)(bl * 8 + hd * 2) * TP * 64;
  fa.K1 = fa.K0 + (size_t)TP * 64;
  fa.V = (const u16*)(ws + OFF_DV) + (size_t)(bl * 4 + hd) * TP * 128;
  f32x16 o[4];
  float linv;
  flash_unit<64, 128, 2, 0>(fa, smem, o, linv);
  float* xb = (float*)smem;
  if (w >= 4) {
#pragma unroll
    for (int v = 0; v < 4; ++v)
#pragma unroll
      for (int e = 0; e < 16; ++e) xb[((w - 4) * 64 + v * 16 + e) * 64 + lane] = o[v][e] * linv;
  }
  __syncthreads();
  if (w < 4) {
    float ss = 0;
#pragma unroll
    for (int v = 0; v < 4; ++v)
#pragma unroll
      for (int e = 0; e < 16; ++e) {
        const float t = o[v][e] * linv - lam * xb[(w * 64 + v * 16 + e) * 64 + lane];
        o[v][e] = t;
        ss += t * t;
      }
    ss += xor32(ss);
    const float rs = rsqrtf(ss * (1.f / 128.f) + EPS) * (1.f - lam_init);
    const int tp = q_t0 + w * 32 + r;
    const size_t m = (size_t)bl * TP + tp;
    attn_store<4>(o, rs, (const u16*)(ws + OFF_Z) + m * 1536 + 1024 + hd * 128, (u16*)(ws + OFF_ACAT) + m * 1536 + 1024 + hd * 128,
                  p.diff_subln_g + l * 128);
  }
  __syncthreads();
}

DEV void attn_mla_unit(const Params& p, int bl, int hd, int q_t0, int n_tiles, char* smem) {
  char* ws = opaque_ptr(p.ws);
  const int tid = opaque_tid(), w = tid >> 6, lane = tid & 63, r = lane & 31;
  FlashArgs fa;
  fa.rpb = nullptr; fa.r0 = 0; fa.lt0 = 4; fa.n_tiles = n_tiles; fa.q_t0 = q_t0;
  fa.Q0 = (const u16*)(ws + OFF_MQ) + (size_t)(bl * 8 + hd) * TP * 96; fa.Q1 = fa.Q0;
  fa.K0 = (const u16*)(ws + OFF_MK) + (size_t)(bl * 8 + hd) * TP * 96; fa.K1 = fa.K0;
  fa.V = (const u16*)(ws + OFF_MV) + (size_t)(bl * 8 + hd) * TP * 64;
  f32x16 o[2];
  float linv;
  flash_unit<96, 64, 1, 0>(fa, smem, o, linv);
  const int tp = q_t0 + w * 32 + r;
  const size_t m = (size_t)bl * TP + tp;
  attn_store<2>(o, linv, (const u16*)(ws + OFF_Z) + m * 1536 + 512 + hd * 64, (u16*)(ws + OFF_ACAT) + m * 1536 + 512 + hd * 64, nullptr);
}

DEV void attn_na_unit(const Params& p, int l, int bl, int hd, int qb, char* smem) {
  char* ws = opaque_ptr(p.ws);
  const int tid = opaque_tid(), w = tid >> 6, lane = tid & 63, r = lane & 31;
  FlashArgs fa;
  fa.Q0 = (const u16*)(ws + OFF_NAQ) + (size_t)(bl * 8 + hd) * TP * 64; fa.Q1 = fa.Q0;
  fa.K0 = (const u16*)(ws + OFF_NAK) + (size_t)(bl * 8 + hd) * TP * 64; fa.K1 = fa.K0;
  fa.V = (const u16*)(ws + OFF_NAV) + (size_t)(bl * 8 + hd) * TP * 64;
  fa.rpb = p.na_rpb + ((size_t)l * 8 + hd) * 15 * 31;
  f32x16 o[2];
  float linv;
  if (qb >= 0) {
    const int r0 = qb * 4;
    const int rlo = min(max(r0 - 4, 0), 120);
    const int rhi = min(max(r0 + 3 - 4, 0), 120) + 8;
    fa.q_t0 = CTXL + r0 * 64;
    fa.r0 = r0;
    fa.lt0 = 4 + rlo;
    fa.n_tiles = 4 + (rhi - rlo);
  } else {
    fa.q_t0 = 0; fa.r0 = 0; fa.lt0 = 4; fa.n_tiles = 4;
  }
  flash_unit<64, 64, 1, 1>(fa, smem, o, linv);
  const int tp = fa.q_t0 + w * 32 + r;
  const size_t m = (size_t)bl * TP + tp;
  attn_store<2>(o, linv, (const u16*)(ws + OFF_Z) + m * 1536 + hd * 64, (u16*)(ws + OFF_ACAT) + m * 1536 + hd * 64, nullptr);
}

DEV void phase_attn(const Params& p, int l, int hf, char* smem) {
  const int nctx = (l == 0) ? 16 : 0;
  for (int rep = 0; rep < REP_DIFF; ++rep)
  for (int u = blockIdx.x; u < 512 + nctx; u += gridDim.x) {
    int pair, q_t0, nt;
    if (u < 512) { pair = u & 7; q_t0 = CTXL + (u >> 3) * 128; nt = 132; }
    else { const int v = u - 512; pair = v >> 1; q_t0 = (v & 1) * 128; nt = 4; }
    attn_diff_unit(p, l, pair >> 2, pair & 3, q_t0, nt, smem);
  }
  for (int rep = 0; rep < REP_MLA; ++rep)
  for (int u = blockIdx.x; u < 512 + 2 * nctx; u += gridDim.x) {
    int pair, q_t0, nt;
    if (u < 512) { pair = (u & 7) + 8 * (u >> 8); q_t0 = CTXL + ((u >> 3) & 31) * 256; nt = 132; }
    else { pair = u - 512 - nctx; q_t0 = 0; nt = 4; if (pair < 0) continue; }
    attn_mla_unit(p, pair >> 3, pair & 7, q_t0, nt, smem);
  }
  for (int rep = 0; rep < REP_NA; ++rep)
  for (int u = blockIdx.x; u < 512 + 3 * nctx; u += gridDim.x) {
    int pair, qb;
    if (u < 512) { pair = (u & 7) + 8 * (u >> 8); qb = (u >> 3) & 31; }
    else { pair = u - 512 - 2 * nctx; qb = -1; if (pair < 0) continue; }
    attn_na_unit(p, l, pair >> 3, pair & 7, qb, smem);
  }
}

DEV void phase_merge(const Params& p, int l, int hf, char* smem) {
  char* ws = opaque_ptr(p.ws);
  const int tid = opaque_tid(), w = tid >> 6, wm = w >> 1, wn = w & 1, lane = tid & 63, h = lane >> 5, r = lane & 31;
  const u16* A = (const u16*)(ws + OFF_ACAT);
  const u16* G = (const u16*)(ws + OFF_G);
  u16* Y = (u16*)(ws + OFF_H) + (size_t)hf * MH * 1024;
  const int nslots = 64 * 8;
  for (int t = blockIdx.x; t < nslots; t += gridDim.x) {
    int mq, nt;
    if (!tile_decode(t, 64, 8, 4, mq, nt)) continue;
    const int mt = (mq >> 5) * 33 + 1 + (mq & 31);
    f32x16 yacc[2][2];
#pragma unroll
    for (int i = 0; i < 2; ++i)
#pragma unroll
      for (int j = 0; j < 2; ++j)
#pragma unroll
        for (int e = 0; e < 16; ++e) yacc[i][j][e] = 0.f;
#pragma unroll 1
    for (int br = 0; br < 3; ++br) {
      f32x16 acc[2][2];
#pragma unroll
      for (int i = 0; i < 2; ++i)
#pragma unroll
        for (int j = 0; j < 2; ++j)
#pragma unroll
          for (int e = 0; e < 16; ++e) acc[i][j][e] = 0.f;
      uint2 gpre[2][2][4];
      auto load_gates = [&]() {
#pragma unroll
        for (int j = 0; j < 2; ++j) {
          const size_t m = (size_t)mt * 256 + wm * 64 + 32 * j + r;
          const u16* grow = G + m * 3072 + br * 1024 + nt * 128 + wn * 64;
#pragma unroll
          for (int i = 0; i < 2; ++i)
#pragma unroll
            for (int g4 = 0; g4 < 4; ++g4) gpre[i][j][g4] = *(const uint2*)(grow + 32 * i + 8 * g4 + 4 * h);
        }
      };
      gemm_main<2, 2, 128, 3>(acc, A + (size_t)mt * 256 * 1536 + br * 512, 1536,
                              (const u16*)(ws + OFF_WBR) + ((size_t)(l * 3 + br) * 1024 + nt * 128) * 512, 512, 512, smem, wm * 64,
                              wn * 64, 64, 64, load_gates);
#pragma unroll
      for (int j = 0; j < 2; ++j) {
#pragma unroll
        for (int i = 0; i < 2; ++i)
#pragma unroll
          for (int g4 = 0; g4 < 4; ++g4) {
            const uint2 gg = gpre[i][j][g4];
            yacc[i][j][4 * g4] += acc[i][j][4 * g4] * __uint_as_float(gg.x << 16);
            yacc[i][j][4 * g4 + 1] += acc[i][j][4 * g4 + 1] * __uint_as_float(gg.x & 0xffff0000u);
            yacc[i][j][4 * g4 + 2] += acc[i][j][4 * g4 + 2] * __uint_as_float(gg.y << 16);
            yacc[i][j][4 * g4 + 3] += acc[i][j][4 * g4 + 3] * __uint_as_float(gg.y & 0xffff0000u);
          }
      }
    }
#pragma unroll
    for (int j = 0; j < 2; ++j) {
      const size_t m = (size_t)mt * 256 + wm * 64 + 32 * j + r;
      u16* yrow = Y + m * 1024 + nt * 128 + wn * 64;
#pragma unroll
      for (int i = 0; i < 2; ++i) {
        float v[16];
#pragma unroll
        for (int e = 0; e < 16; ++e) v[e] = yacc[i][j][e];
        store_row32(yrow + 32 * i, v, h);
      }
    }
  }
  if (l == 0) {
    for (int u = (int)gridDim.x - 1 - (int)blockIdx.x; u < 32; u += gridDim.x) {
      const int mt = (u >> 4) * 33, nt64 = u & 15;
      f32x16 yacc[1][2];
#pragma unroll
      for (int j = 0; j < 2; ++j)
#pragma unroll
        for (int e = 0; e < 16; ++e) yacc[0][j][e] = 0.f;
#pragma unroll 1
      for (int br = 0; br < 3; ++br) {
        f32x16 acc[1][2];
#pragma unroll
        for (int j = 0; j < 2; ++j)
#pragma unroll
          for (int e = 0; e < 16; ++e) acc[0][j][e] = 0.f;
        uint2 gpre[2][4];
        auto load_gates = [&]() {
#pragma unroll
          for (int j = 0; j < 2; ++j) {
            const size_t m = (size_t)mt * 256 + wm * 64 + 32 * j + r;
            const u16* grow = G + m * 3072 + br * 1024 + nt64 * 64 + wn * 32;
#pragma unroll
            for (int g4 = 0; g4 < 4; ++g4) gpre[j][g4] = *(const uint2*)(grow + 8 * g4 + 4 * h);
          }
        };
        gemm_main<1, 2, 64, 3>(acc, A + (size_t)mt * 256 * 1536 + br * 512, 1536,
                               (const u16*)(ws + OFF_WBR) + ((size_t)(l * 3 + br) * 1024 + nt64 * 64) * 512, 512, 512, smem, wm * 64,
                               wn * 32, 64, 64, load_gates);
#pragma unroll
        for (int j = 0; j < 2; ++j)
#pragma unroll
          for (int g4 = 0; g4 < 4; ++g4) {
            const uint2 gg = gpre[j][g4];
            yacc[0][j][4 * g4] += acc[0][j][4 * g4] * __uint_as_float(gg.x << 16);
            yacc[0][j][4 * g4 + 1] += acc[0][j][4 * g4 + 1] * __uint_as_float(gg.x & 0xffff0000u);
            yacc[0][j][4 * g4 + 2] += acc[0][j][4 * g4 + 2] * __uint_as_float(gg.y << 16);
            yacc[0][j][4 * g4 + 3] += acc[0][j][4 * g4 + 3] * __uint_as_float(gg.y & 0xffff0000u);
          }
      }
#pragma unroll
      for (int j = 0; j < 2; ++j) {
        const size_t m = (size_t)mt * 256 + wm * 64 + 32 * j + r;
        float v[16];
#pragma unroll
        for (int e = 0; e < 16; ++e) v[e] = yacc[0][j][e];
        store_row32(Y + m * 1024 + nt64 * 64 + wn * 32, v, h);
      }
    }
  }
}

DEV void phase_outproj(const Params& p, int l, int hf, char* smem) {
  char* ws = opaque_ptr(p.ws);
  const int tid = opaque_tid(), w = tid >> 6, wm = w >> 1, wn = w & 1, lane = tid & 63, h = lane >> 5, r = lane & 31;
  const u16* Y = (const u16*)(ws + OFF_H) + (size_t)hf * MH * 1024;
  const u16* W = (const u16*)(ws + OFF_WOUT) + (size_t)l * 1024 * 1024;
  const float* mod = (const float*)(ws + OFF_MOD) + (size_t)l * 5 * 3072;
  const float* xs = l == 0 ? p.x : p.out;
  const int nslots = 64 * 8;
  for (int t = blockIdx.x; t < nslots; t += gridDim.x) {
    int mq, nt;
    if (!tile_decode(t, 64, 8, 4, mq, nt)) continue;
    const int mt = (mq >> 5) * 33 + 1 + (mq & 31);
    f32x16 acc[2][2];
#pragma unroll
    for (int i = 0; i < 2; ++i)
#pragma unroll
      for (int j = 0; j < 2; ++j)
#pragma unroll
        for (int e = 0; e < 16; ++e) acc[i][j][e] = 0.f;
    float4 xpre[2][2][4];
    auto load_x = [&]() {
#pragma unroll
      for (int j = 0; j < 2; ++j) {
        const int m = mt * 256 + wm * 64 + 32 * j + r;
        const int bl = m / TP, tp = m - bl * TP;
        const int b = hf * 2 + bl;
        const float* src = (tp < CTXL) ? p.ctx + ((size_t)b * CTXL + tp) * DM : xs + ((size_t)b * SEQ + (tp - CTXL)) * DM;
#pragma unroll
        for (int i = 0; i < 2; ++i)
#pragma unroll
          for (int g4 = 0; g4 < 4; ++g4) xpre[i][j][g4] = *(const float4*)(src + nt * 128 + wn * 64 + 32 * i + 8 * g4 + 4 * h);
      }
    };
    gemm_main<2, 2, 128, 3>(acc, Y + (size_t)mt * 256 * 1024, 1024, W + (size_t)nt * 128 * 1024, 1024, 1024, smem, wm * 64, wn * 64,
                            64, 64, load_x);
#pragma unroll
    for (int j = 0; j < 2; ++j) {
      const int m = mt * 256 + wm * 64 + 32 * j + r;
      const int bl = m / TP, tp = m - bl * TP;
      const int b = hf * 2 + bl;
      const int n0 = nt * 128 + wn * 64;
      const float* src;
      float* dst;
      const float* gate;
      if (tp < CTXL) {
        src = p.ctx + ((size_t)b * CTXL + tp) * DM;
        dst = (float*)(ws + OFF_CTX1) + ((size_t)b * CTXL + tp) * DM;
        gate = mod + 4 * 3072 + 2048;
      } else {
        src = xs + ((size_t)b * SEQ + (tp - CTXL)) * DM;
        dst = p.out + ((size_t)b * SEQ + (tp - CTXL)) * DM;
        gate = mod + b * 3072 + 2048;
      }
#pragma unroll
      for (int i = 0; i < 2; ++i)
#pragma unroll
        for (int g4 = 0; g4 < 4; ++g4) {
          const int n = n0 + 32 * i + 8 * g4 + 4 * h;
          const float4 xv = xpre[i][j][g4];
          const float4 gv = *(const float4*)(gate + n);
          float4 o;
          o.x = xv.x + gv.x * acc[i][j][4 * g4];
          o.y = xv.y + gv.y * acc[i][j][4 * g4 + 1];
          o.z = xv.z + gv.z * acc[i][j][4 * g4 + 2];
          o.w = xv.w + gv.w * acc[i][j][4 * g4 + 3];
          *(float4*)(dst + n) = o;
        }
    }
  }
  if (l == 0) {
    for (int u = (int)gridDim.x - 1 - (int)blockIdx.x; u < 32; u += gridDim.x) {
      const int mt = (u >> 4) * 33, nt64 = u & 15;
      f32x16 acc[1][2];
#pragma unroll
      for (int j = 0; j < 2; ++j)
#pragma unroll
        for (int e = 0; e < 16; ++e) acc[0][j][e] = 0.f;
      gemm_main<1, 2, 64, 3>(acc, Y + (size_t)mt * 256 * 1024, 1024, W + (size_t)nt64 * 64 * 1024, 1024, 1024, smem, wm * 64, wn * 32);
      const float* gate = mod + 4 * 3072 + 2048;
#pragma unroll
      for (int j = 0; j < 2; ++j) {
        const int m = mt * 256 + wm * 64 + 32 * j + r;
        const int bl = m / TP, tp = m - bl * TP;
        float* dst = (float*)(ws + OFF_CTX1) + ((size_t)(hf * 2 + bl) * CTXL + tp) * DM;
#pragma unroll
        for (int g4 = 0; g4 < 4; ++g4) {
          const int n = nt64 * 64 + wn * 32 + 8 * g4 + 4 * h;
          const float4 xv = *(const float4*)(p.ctx + ((size_t)(hf * 2 + bl) * CTXL + tp) * DM + n);
          const float4 gv = *(const float4*)(gate + n);
          float4 o;
          o.x = xv.x + gv.x * acc[0][j][4 * g4];
          o.y = xv.y + gv.y * acc[0][j][4 * g4 + 1];
          o.z = xv.z + gv.z * acc[0][j][4 * g4 + 2];
          o.w = xv.w + gv.w * acc[0][j][4 * g4 + 3];
          *(float4*)(dst + n) = o;
        }
      }
    }
  }
}

#define XB_TMO      128
#define XB_XCNT(j)  (256  + 64 * (j))
#define XB_XSUB(j)  (1280 + 64 * (j))
#define XB_XGEN(j)  (2304 + 64 * (j))
#define XB_TOP      3328
#define XB_TOPGEN   3392
#define XB_SPIN_CAP (1u << 18)
#define LAS __attribute__((address_space(3)))
DEV unsigned xb_ld(unsigned* p) { return __hip_atomic_load(p, __ATOMIC_RELAXED, __HIP_MEMORY_SCOPE_AGENT); }
DEV unsigned xb_add(unsigned* p, unsigned v) { return __hip_atomic_fetch_add(p, v, __ATOMIC_RELAXED, __HIP_MEMORY_SCOPE_AGENT); }
DEV unsigned xb_xcc_id() { return (unsigned)__builtin_amdgcn_s_getreg((3 << 11) | 20) & 0xFu; }
#define XB_SPIN(cond, bar) do { unsigned _sp = 0; while (cond) { __builtin_amdgcn_s_sleep(1); \
    if ((++_sp & 255u) == 0u) { if (xb_ld(&(bar)[XB_TMO])) break; if (_sp > XB_SPIN_CAP) { atomicAdd(&(bar)[XB_TMO], 1u); break; } } } } while (0)
DEV void xcd_barrier_complete(unsigned* bar, unsigned x, unsigned& nloc, unsigned& nx) {
  const unsigned G = gridDim.x;
  unsigned sum, cnt, mine, sp = 0u;
  for (;;) {
    sum = 0u; cnt = 0u; mine = 0u;
#pragma unroll
    for (unsigned j = 0; j < 16; ++j) { const unsigned c = xb_ld(&bar[XB_XCNT(j)]); sum += c; cnt += (c > 0u) ? 1u : 0u; mine = (j == x) ? c : mine; }
    if (sum == G) break;
    __builtin_amdgcn_s_sleep(1);
    if ((++sp & 255u) == 0u) { if (xb_ld(&bar[XB_TMO])) break; if (sp > XB_SPIN_CAP) { atomicAdd(&bar[XB_TMO], 1u); break; } }
  }
  nloc = mine > 0u ? mine : 1u; nx = cnt > 0u ? cnt : 1u;
}
DEV void xcd_barrier(unsigned* bar, unsigned x, volatile LAS unsigned* st) {
  asm volatile("s_waitcnt vmcnt(0)" ::: "memory");
  __syncthreads();
  if (threadIdx.x == 0) {
    __builtin_amdgcn_s_waitcnt(0);
    unsigned nloc = st[0], nx = st[1];
    if (nloc == 0u) { xcd_barrier_complete(bar, x, nloc, nx); st[0] = nloc; st[1] = nx; }
    const unsigned old = xb_add(&bar[XB_XSUB(x)], 1u);
    const unsigned gen = old / nloc;
    if (old + 1u == (gen + 1u) * nloc) {
      __builtin_amdgcn_fence(__ATOMIC_RELEASE, "agent");
      asm volatile("s_waitcnt vmcnt(0)" ::: "memory");
      const unsigned og = xb_add(&bar[XB_TOP], 1u);
      const unsigned tg = og / nx;
      if (og + 1u == (tg + 1u) * nx) xb_add(&bar[XB_TOPGEN], 1u);
      else XB_SPIN(xb_ld(&bar[XB_TOPGEN]) == tg, bar);
      __builtin_amdgcn_fence(__ATOMIC_ACQUIRE, "agent");
      xb_add(&bar[XB_XGEN(x)], 1u);
      asm volatile("s_waitcnt vmcnt(0)" ::: "memory");
    } else {
      XB_SPIN(xb_ld(&bar[XB_XGEN(x)]) == gen, bar);
      __builtin_amdgcn_fence(__ATOMIC_ACQUIRE, "agent");
      asm volatile("s_waitcnt vmcnt(0)" ::: "memory");
    }
  }
  __syncthreads();
}

constexpr int N_PHASES = 23;
DEV void run_phase(const Params& p, int ph, char* smem) {
  if (ph == 0) { phase_prologue(p, smem); return; }
  const int q = ph - 1, l = q / 11, r = q % 11;
  if (r == 0) { phase_norm(p, l); return; }
  const int hf = (r - 1) / 5, k = (r - 1) % 5;
  switch (k) {
    case 0: for (int rep = 0; rep < REP_INPROJ; ++rep) phase_inproj(p, l, hf, smem); break;
    case 1: phase_upproj(p, l, hf, smem); break;
    case 2: phase_attn(p, l, hf, smem); break;
    case 3: phase_merge(p, l, hf, smem); break;
    default: phase_outproj(p, l, hf, smem); break;
  }
}

__global__ void __launch_bounds__(512) mega_kernel(Params p, int ph_begin, int ph_end) {
  extern __shared__ __attribute__((aligned(16))) char smem[];
  volatile LAS unsigned* st = (volatile LAS unsigned*)(smem + SMEM_BYTES);
  unsigned* bar = (unsigned*)(p.ws + OFF_BAR);
  if (threadIdx.x < 2) st[threadIdx.x] = 0u;
  __syncthreads();
  const unsigned xcc = xb_xcc_id();
  if (threadIdx.x == 0) (void)xb_add(&bar[XB_XCNT(xcc)], 1u);
  for (int ph = ph_begin; ph < ph_end; ++ph) {
    run_phase(p, ph, smem);
    if (ph + 1 < ph_end) {
      if (ph == ph_begin) cg::this_grid().sync();
      else xcd_barrier(bar, xcc, st);
    }
  }
}

extern "C" void kernel_launch(void* const* d_in, const int* in_sizes, int n_in, void* d_out, int out_size, void* d_ws,
                              size_t ws_size, hipStream_t stream) {
  if (ws_size < WS_NEED) {
    fprintf(stderr, "workspace too small: %zu < %zu\n", ws_size, (size_t)WS_NEED);
    return;
  }
  Params p{};
  const float** pp = (const float**)&p;
  for (int i = 0; i < 26; ++i) pp[i] = (const float*)d_in[i];
  p.out = (float*)d_out;
  p.ws = (char*)d_ws;
  static int grid_blocks = 0;
  if (!grid_blocks) {
    hipFuncSetAttribute((const void*)mega_kernel, hipFuncAttributeMaxDynamicSharedMemorySize, SMEM_BYTES + 16);
    int dev = 0, cus = 0, per_cu = 0;
    hipGetDevice(&dev);
    hipDeviceGetAttribute(&cus, hipDeviceAttributeMultiprocessorCount, dev);
    hipOccupancyMaxActiveBlocksPerMultiprocessor(&per_cu, mega_kernel, 512, SMEM_BYTES + 16);
    if (per_cu < 1) per_cu = 1;
    grid_blocks = cus * per_cu;
  }
#ifdef MULTI_LAUNCH
  for (int ph = 0; ph < N_PHASES; ++ph)
    hipLaunchKernelGGL(mega_kernel, dim3(grid_blocks), dim3(512), SMEM_BYTES + 16, stream, p, ph, ph + 1);
#else
  hipMemsetAsync((char*)d_ws + OFF_BAR, 0, SZ_BAR, stream);
  int b = 0, e = N_PHASES;
  void* args[] = {&p, &b, &e};
  hipError_t err = hipLaunchCooperativeKernel((const void*)mega_kernel, dim3(grid_blocks), dim3(512), args, SMEM_BYTES + 16, stream);
  if (err != hipSuccess) fprintf(stderr, "cooperative launch failed: %s (grid %d)\n", hipGetErrorString(err), grid_blocks);
#endif
}
```
